# Optimizing an MI355X kernel written in HIP

```python
import math
import jax, jax.numpy as jnp
from jax import lax
import numpy as np

D_MODEL = 1024
BATCH = 32
SEQ = 256
DEPTH = 1
DEC_BATCH = 8
DEC_SEQ = 2048
PAST_LEN = 256

GRID_W = 64
N_HEADS = 8
HEAD_DIM = 64
V_DIM = 2 * HEAD_DIM
D_ATTN = N_HEADS * 2 * HEAD_DIM
N_POOL_GROUPS = 4
POOL_WINDOWS = (2, 4, 8, 16)
D_POOL = D_MODEL // 2
POOL_GROUP_DIM = D_POOL // N_POOL_GROUPS
D_FF = 2816
CONV_W = 3
ROPE_BASE = 10000.0
Q_BLOCK = 128
EPS = 1e-6
D_IN = D_POOL + 3 * D_ATTN + 2 * D_MODEL

kernel_name = "hybrid_pool_diffattn_prefix_dit_step"


def rms_norm(x, g):
    xf = x.astype(jnp.float32)
    y = xf * lax.rsqrt(jnp.mean(xf * xf, axis=-1, keepdims=True) + EPS)
    return (y * g.astype(jnp.float32)).astype(x.dtype)


def modulate(x, g, shift, scale):
    return rms_norm(x, g) * (1 + scale[:, None, :]) + shift[:, None, :]


def rope_2d(x):
    n_tok = x.shape[1]
    rows = n_tok // GRID_W
    row = jnp.repeat(jnp.arange(rows, dtype=jnp.float32), GRID_W)
    col = jnp.tile(jnp.arange(GRID_W, dtype=jnp.float32), rows)
    n_freq = HEAD_DIM // 4
    inv = ROPE_BASE ** (-jnp.arange(n_freq, dtype=jnp.float32) / n_freq)
    ang = jnp.stack([row[:, None] * inv, col[:, None] * inv], axis=1)
    cos = jnp.cos(ang)[None, :, None, None]
    sin = jnp.sin(ang)[None, :, None, None]
    xr = x.astype(jnp.float32).reshape(x.shape[:-1] + (2, 2, n_freq))
    x1 = xr[..., 0, :]
    x2 = xr[..., 1, :]
    out = jnp.stack([x1 * cos - x2 * sin, x2 * cos + x1 * sin], axis=-2)
    return out.reshape(x.shape).astype(x.dtype)


def multi_pool(u, w_pool, pool_scale):
    B, S, _ = u.shape
    ug = u.astype(jnp.float32).reshape(B, S, N_POOL_GROUPS, POOL_GROUP_DIM)
    cs = jnp.concatenate([jnp.zeros((B, 1, N_POOL_GROUPS, POOL_GROUP_DIM), jnp.float32),
                          jnp.cumsum(ug, axis=1)], axis=1)
    t = jnp.arange(S)
    outs = []
    for gi, w in enumerate(POOL_WINDOWS):
        lo = jnp.clip(t - w // 2, 0, S)
        hi = jnp.clip(t + (w - w // 2), 0, S)
        csg = cs[:, :, gi]
        s = jnp.take(csg, hi, axis=1) - jnp.take(csg, lo, axis=1)
        cnt = (hi - lo).astype(jnp.float32)[None, :, None]
        outs.append(s / cnt - ug[:, :, gi])
    pooled = jnp.stack(outs, axis=2)
    mixed = jnp.einsum('bsgc,gce->bsge', pooled, w_pool.astype(jnp.float32)).reshape(B, S, D_POOL)
    return (mixed * pool_scale.astype(jnp.float32)).astype(u.dtype)


def diff_attention(q, k, v, lam):
    B, S = q.shape[0], q.shape[1]
    nb = S // Q_BLOCK
    qb = q.reshape(B, nb, Q_BLOCK, N_HEADS, 2, HEAD_DIM).swapaxes(0, 1)
    scale = HEAD_DIM ** -0.5
    vf = v.astype(jnp.float32)

    def block(qi):
        s = jnp.einsum('bqhmd,bkhmd->bhmqk', qi, k).astype(jnp.float32) * scale
        p = jax.nn.softmax(s, axis=-1)
        a = p[:, :, 0] - lam * p[:, :, 1]
        return jnp.einsum('bhqk,bkhe->bqhe', a, vf)

    o = lax.map(block, qb)
    return o.swapaxes(0, 1).reshape(B, S, N_HEADS, V_DIM)


def dwconv3(a, w, b):
    ap = jnp.pad(a, ((0, 0), (1, 1), (0, 0)))
    return ap[:, :-2] * w[0] + ap[:, 1:-1] * w[1] + ap[:, 2:] * w[2] + b


def trunk_layer(x, mod, lam_init, w_in, w_pool, pool_scale, w_proj_a, w_proj_b, w_out,
                lam_q1, lam_k1, lam_q2, lam_k2, subln_w, norm1_w, norm2_w,
                w_ffn_in, ffn_conv_w, ffn_conv_b, w_ffn_out, ctx_k=None, ctx_v=None):
    B, S, _ = x.shape
    shift1, scale1, gate1, shift2, scale2, gate2 = jnp.split(mod, 6, axis=-1)

    h = modulate(x, norm1_w, shift1, scale1)
    proj = h @ w_in
    u, q, k, v, gates = jnp.split(
        proj, [D_POOL, D_POOL + D_ATTN, D_POOL + 2 * D_ATTN, D_POOL + 3 * D_ATTN], axis=-1)
    q = q.reshape(B, S, N_HEADS, 2, HEAD_DIM)
    k = k.reshape(B, S, N_HEADS, 2, HEAD_DIM)
    v = v.reshape(B, S, N_HEADS, V_DIM)

    y_a = multi_pool(u, w_pool, pool_scale) @ w_proj_a

    lam = (jnp.exp(jnp.sum(lam_q1.astype(jnp.float32) * lam_k1.astype(jnp.float32)))
           - jnp.exp(jnp.sum(lam_q2.astype(jnp.float32) * lam_k2.astype(jnp.float32)))
           + lam_init)
    if ctx_k is None:
        attn = diff_attention(q, k, v, lam)
    else:
        q = rope_2d(q)
        k_lat = rope_2d(k)
        k_all = jnp.concatenate([ctx_k.astype(k_lat.dtype), k_lat], axis=1)
        v_all = jnp.concatenate([ctx_v.astype(v.dtype), v], axis=1)
        attn = diff_attention(q, k_all, v_all, lam)
    o = rms_norm(attn, subln_w) * (1 - lam_init)
    y_b = o.reshape(B, S, D_ATTN).astype(x.dtype) @ w_proj_b

    g_a, g_b = jnp.split(jax.nn.sigmoid(gates), 2, axis=-1)
    x = x + gate1[:, None, :] * ((g_a * y_a + g_b * y_b) @ w_out)

    h = modulate(x, norm2_w, shift2, scale2)
    a, up = jnp.split(h @ w_ffn_in, 2, axis=-1)
    a = dwconv3(a, ffn_conv_w, ffn_conv_b)
    x = x + gate2[:, None, :] * ((jax.nn.silu(a) * up) @ w_ffn_out)
    return x, k, v


def setup_inputs(seed: int = 0) -> dict:
    key = jax.random.key(seed)
    ks = jax.random.split(key, 26)
    nrm = jax.random.normal
    f32 = jnp.float32
    return {
        "x_prompt": nrm(ks[0], (BATCH, SEQ, D_MODEL), f32),
        "x_sample": nrm(ks[1], (DEC_BATCH, DEC_SEQ, D_MODEL), f32),
        "cache_k": nrm(ks[2], (DEC_BATCH, DEPTH, PAST_LEN, N_HEADS, 2, HEAD_DIM), f32),
        "cache_v": nrm(ks[3], (DEC_BATCH, DEPTH, PAST_LEN, N_HEADS, V_DIM), f32),
        "c": nrm(ks[4], (DEC_BATCH, D_MODEL), f32),
        "c_ctx": nrm(ks[5], (D_MODEL,), f32),
        "w_ada": nrm(ks[6], (DEPTH, D_MODEL, 6 * D_MODEL), f32) * D_MODEL ** -0.5,
        "b_ada": nrm(ks[7], (DEPTH, 6 * D_MODEL), f32) * 0.01,
        "w_in": nrm(ks[8], (DEPTH, D_MODEL, D_IN), f32) * D_MODEL ** -0.5,
        "w_pool": nrm(ks[9], (DEPTH, N_POOL_GROUPS, POOL_GROUP_DIM, POOL_GROUP_DIM), f32) * POOL_GROUP_DIM ** -0.5,
        "pool_scale": 1.0 + 0.1 * nrm(ks[10], (DEPTH, D_POOL), f32),
        "w_proj_a": nrm(ks[11], (DEPTH, D_POOL, D_MODEL), f32) * D_POOL ** -0.5,
        "w_proj_b": nrm(ks[12], (DEPTH, D_ATTN, D_MODEL), f32) * D_ATTN ** -0.5,
        "w_out": nrm(ks[13], (DEPTH, D_MODEL, D_MODEL), f32) * D_MODEL ** -0.5,
        "lam_q1": nrm(ks[14], (DEPTH, HEAD_DIM), f32) * 0.1,
        "lam_k1": nrm(ks[15], (DEPTH, HEAD_DIM), f32) * 0.1,
        "lam_q2": nrm(ks[16], (DEPTH, HEAD_DIM), f32) * 0.1,
        "lam_k2": nrm(ks[17], (DEPTH, HEAD_DIM), f32) * 0.1,
        "subln_w": 1.0 + 0.1 * nrm(ks[18], (DEPTH, V_DIM), f32),
        "norm1_w": 1.0 + 0.1 * nrm(ks[19], (DEPTH, D_MODEL), f32),
        "norm2_w": 1.0 + 0.1 * nrm(ks[20], (DEPTH, D_MODEL), f32),
        "w_ffn_in": nrm(ks[21], (DEPTH, D_MODEL, 2 * D_FF), f32) * D_MODEL ** -0.5,
        "ffn_conv_w": nrm(ks[22], (DEPTH, CONV_W, D_FF), f32) * CONV_W ** -0.5,
        "ffn_conv_b": nrm(ks[23], (DEPTH, D_FF), f32) * 0.01,
        "w_ffn_out": nrm(ks[24], (DEPTH, D_FF, D_MODEL), f32) * D_FF ** -0.5,
        "final_norm_w": 1.0 + 0.1 * nrm(ks[25], (D_MODEL,), f32),
    }


def reference(x_prompt, x_sample, cache_k, cache_v, c, c_ctx, w_ada, b_ada, w_in, w_pool, pool_scale,
              w_proj_a, w_proj_b, w_out, lam_q1, lam_k1, lam_q2, lam_k2, subln_w, norm1_w, norm2_w,
              w_ffn_in, ffn_conv_w, ffn_conv_b, w_ffn_out, final_norm_w):
    xp = x_prompt
    xs = x_sample
    k_list = []
    v_list = []
    for i in range(DEPTH):
        lam_init = 0.8 - 0.6 * math.exp(-0.3 * i)
        mod_ctx = jax.nn.silu(c_ctx)[None, :] @ w_ada[i] + b_ada[i]
        mod_lat = jax.nn.silu(c) @ w_ada[i] + b_ada[i]
        layer_w = dict(w_in=w_in[i], w_pool=w_pool[i], pool_scale=pool_scale[i], w_proj_a=w_proj_a[i],
                       w_proj_b=w_proj_b[i], w_out=w_out[i], lam_q1=lam_q1[i], lam_k1=lam_k1[i],
                       lam_q2=lam_q2[i], lam_k2=lam_k2[i], subln_w=subln_w[i], norm1_w=norm1_w[i],
                       norm2_w=norm2_w[i], w_ffn_in=w_ffn_in[i], ffn_conv_w=ffn_conv_w[i],
                       ffn_conv_b=ffn_conv_b[i], w_ffn_out=w_ffn_out[i])
        xp, k_ctx, v_ctx = trunk_layer(xp, mod_ctx, lam_init, **layer_w)
        k_list.append(k_ctx)
        v_list.append(v_ctx)
        xs, _, _ = trunk_layer(xs, mod_lat, lam_init, ctx_k=cache_k[:, i], ctx_v=cache_v[:, i], **layer_w)
    y_prompt = rms_norm(xp, final_norm_w)
    y_sample = rms_norm(xs, final_norm_w)
    new_cache_k = jnp.stack(k_list, axis=1)
    new_cache_v = jnp.stack(v_list, axis=1)
    return (y_prompt, y_sample, new_cache_k, new_cache_v)
```

```cpp
#include <hip/hip_runtime.h>
#include <cstdio>
#include <cstdint>

constexpr int NWAVES = 8;
constexpr int DM = 1024, TOK_P = 8192, TOK_S = 16384, MTOK = 24576, SEQ_P = 256, SEQ_S = 2048, LKV_S = 2304;
constexpr int DIN = 5632, DFF = 2816, DPOOL = 512;
constexpr float EPS = 1e-6f;
constexpr size_t MiB = 1u << 20;
constexpr size_t WS_CTL = 0, CTL_ZERO_BYTES = 1 * MiB;
constexpr size_t WS_MISC = 1 * MiB;
constexpr size_t MISC_ROPEC = 256 * 1024, MISC_ROPES = 260 * 1024, MISC_LAM = 320 * 1024;
constexpr size_t WS_WIN = 2 * MiB, WS_WPA = 13 * MiB, WS_WPB = 14 * MiB, WS_WOUT = 16 * MiB;
constexpr size_t WS_H = 18 * MiB;
constexpr size_t WS_U = 66 * MiB;
constexpr size_t WS_Q = 90 * MiB;
constexpr size_t WS_KP = 138 * MiB, WS_KS = 154 * MiB;
constexpr size_t WS_VP = 190 * MiB, WS_VS = 206 * MiB;
constexpr size_t WS_END = 242 * MiB;
constexpr size_t WS_MIXED = WS_H, WS_MERGED = WS_H, WS_YA = WS_KP, WS_YB = WS_VP;
constexpr size_t WS_WFI = WS_U, WS_WFO = WS_U + 11 * MiB;
constexpr size_t WS_AU = WS_Q, WS_ACT = 178 * MiB;
static_assert(WS_AU + (size_t)8192 * 5632 * 2 <= WS_ACT && WS_ACT + (size_t)8192 * 2816 * 2 <= WS_END, "ffn chunk buffers");
constexpr int CW_TMO = 0, CW_CODE = 1, CW_BAR = 4096;
constexpr size_t OUT_K = 25165824, OUT_V = 33554432;
constexpr int RING_OFF = 0, RING_BYTES = 131072;
constexpr int LDSCTL_OFF = RING_BYTES, MISC_OFF = LDSCTL_OFF + 320;
constexpr int LDS_BYTES = 147456;

namespace pg8 {
#define PG8_LAS __attribute__((address_space(3)))
typedef unsigned short bf16_t;
typedef short bf16x8 __attribute__((ext_vector_type(8)));
typedef float f32x4 __attribute__((ext_vector_type(4)));
typedef unsigned u32x4 __attribute__((ext_vector_type(4)));
constexpr int BM = 256, BK = 64, HALF = 128, HTB = HALF * BK * 2  , STAGE_BYTES = 8 * HTB, NXCD = 8, WGM = 8;

__host__ __device__ __forceinline__ int lds_byte(int r, int c) { const int st = (r >> 4) * 2 + (c >> 5), rr = r & 15, cc = c & 31, ob = rr * 64 + cc * 2; return st * 1024 + (ob ^ (((ob >> 9) & 1) << 5)); }
__host__ __device__ __forceinline__ void stage_rc(int b, int& R, int& C) { const int st = b / 1024, sb = b % 1024, swz = sb ^ (((sb >> 9) & 1) << 5); R = (st >> 1) * 16 + swz / 64; C = (st & 1) * 32 + (swz % 64) / 2; }
__host__ __device__ __forceinline__ int perm32(int rho) { const int n = rho >> 4, i = rho & 15; return 8 * (i >> 2) + 4 * n + (i & 3); }

struct Unit { int pm, pn; };
struct Gemm { const bf16_t* A; const bf16_t* Bt; int M, N, K; };

struct StaticOrder {
    int nM, nN, nwg, G, c;
    __host__ __device__ void init(int M, int N, int G_, int c_) { nM = M / BM; nN = N / BM; nwg = nM * nN; G = G_; c = c_; }
    __host__ __device__ bool next(int i, Unit& u) const {
        const long L = (long)i * G + c; if (L >= nwg) return false;
        int wgid = (int)L; { const int q = nwg / NXCD, r = nwg % NXCD, xcd = wgid % NXCD, off = wgid / NXCD; wgid = (xcd < r ? xcd * (q + 1) : r * (q + 1) + (xcd - r) * q) + off; }
        const int nig = WGM * nN, gid = wgid / nig, fm = gid * WGM, gsz = (nM - fm) < WGM ? (nM - fm) : WGM;
        u.pm = fm + ((wgid % nig) % gsz); u.pn = (wgid % nig) / gsz; return true;
    }
    __device__ __forceinline__ void a_ready(const Unit&) const {}
    __device__ __forceinline__ void done(const Unit&) const {}
};

__device__ __forceinline__ unsigned cvt_pk_bf16(float lo, float hi) { unsigned r; asm volatile("v_cvt_pk_bf16_f32 %0, %1, %2" : "=v"(r) : "v"(lo), "v"(hi)); return r; }
typedef unsigned u32x2 __attribute__((ext_vector_type(2)));
__device__ __forceinline__ u32x2 pack4(const f32x4 v) { u32x2 w; w.x = cvt_pk_bf16(v[0], v[1]); w.y = cvt_pk_bf16(v[2], v[3]); return w; }

struct EpiStoreBf16 {
    static constexpr bool PERM = false, AFTER_DRAIN = false;
    bf16_t* O; int ldc;
    __device__ __forceinline__ void operator()(f32x4 (&acc)[2][2][4][2], const Unit& u, int wr, int wc, int fr, int fq) const {
#pragma unroll
        for (int ai = 0; ai < 2; ++ai)
#pragma unroll
            for (int m = 0; m < 4; ++m) { bf16_t* rowp = O + (size_t)(u.pm * BM + ai * HALF + wr * 64 + m * 16 + fr) * ldc + u.pn * BM + wc * 32 + 4 * fq;
#pragma unroll
                for (int bj = 0; bj < 2; ++bj)
#pragma unroll
                    for (int n = 0; n < 2; ++n) *(u32x2*)(rowp + bj * HALF + n * 16) = pack4(acc[ai][bj][m][n]); }
    }
};

struct EpiResid {
    static constexpr bool PERM = false, AFTER_DRAIN = false;
    const float* xin_p; const float* xin_s; float* out; const float* mod; int goff; int row_base;
    __device__ __forceinline__ void operator()(f32x4 (&acc)[2][2][4][2], const Unit& u, int wr, int wc, int fr, int fq) const {
        const int grow0 = row_base + u.pm * BM; const bool smp = grow0 >= 8192;
        const int col0 = u.pn * BM + wc * 32 + 4 * fq;
        const float* xin = (smp ? xin_s + (size_t)(grow0 - 8192) * 1024 : xin_p + (size_t)grow0 * 1024) + col0;
        const float* gate = mod + (smp ? 1 + ((grow0 - 8192) >> 11) : 0) * 6144 + goff + col0;
        float* o = out + (size_t)grow0 * 1024 + col0;
        f32x4 g[2][2];
#pragma unroll
        for (int bj = 0; bj < 2; ++bj)
#pragma unroll
            for (int n = 0; n < 2; ++n) g[bj][n] = *(const f32x4*)(gate + bj * HALF + n * 16);
#pragma unroll
        for (int ai = 0; ai < 2; ++ai)
#pragma unroll
            for (int m = 0; m < 4; ++m) { int rl = ai * HALF + wr * 64 + m * 16 + fr; asm volatile("" : "+v"(rl)); const size_t off = (size_t)rl * 1024;
#pragma unroll
                for (int bj = 0; bj < 2; ++bj)
#pragma unroll
                    for (int n = 0; n < 2; ++n) { const f32x4 x = *(const f32x4*)(xin + off + bj * HALF + n * 16); *(f32x4*)(o + off + bj * HALF + n * 16) = x + g[bj][n] * acc[ai][bj][m][n]; }
                if (m & 1) asm volatile("" ::: "memory"); }
    }
};

struct EpiProj {
    static constexpr bool PERM = false, AFTER_DRAIN = false;
    unsigned char* ws; float* out;
    __device__ __forceinline__ void operator()(f32x4 (&acc)[2][2][4][2], const Unit& u, int wr, int wc, int fr, int fq) const {
        const int pn = u.pn, grow0 = u.pm * BM; const bool smp = u.pm >= 32;
        const int sb = (grow0 - 8192) >> 11, st0 = (grow0 - 8192) & 2047;
        const size_t kvrow = smp ? (size_t)(sb * 2304 + 256 + st0) : (size_t)grow0;
        bf16_t* d16; int ld16; float* d32 = nullptr;
        if (pn < 2)       { d16 = (bf16_t*)(ws + WS_U) + (size_t)grow0 * 512 + pn * BM; ld16 = 512; }
        else if (pn < 6)  { d16 = (bf16_t*)(ws + WS_Q) + (size_t)grow0 * 1024 + (pn - 2) * BM; ld16 = 1024; }
        else if (pn < 10) { d16 = (bf16_t*)(ws + (smp ? WS_KS : WS_KP)) + kvrow * 1024 + (pn - 6) * BM; ld16 = 1024; if (!smp) d32 = out + OUT_K + (size_t)grow0 * 1024 + (pn - 6) * BM; }
        else if (pn < 14) { d16 = (bf16_t*)(ws + (smp ? WS_VS : WS_VP)) + kvrow * 1024 + (pn - 10) * BM; ld16 = 1024; if (!smp) d32 = out + OUT_V + (size_t)grow0 * 1024 + (pn - 10) * BM; }
        else              { d16 = (bf16_t*)out + (size_t)grow0 * 2048 + (pn - 14) * BM; ld16 = 2048; }
        const bool do_rope = smp && pn >= 2 && pn < 10, do_sig = pn >= 14;
        const float* ropeC = (const float*)(ws + WS_MISC + MISC_ROPEC) + 4 * fq; const float* ropeS = (const float*)(ws + WS_MISC + MISC_ROPES) + 4 * fq;
#pragma unroll
        for (int ai = 0; ai < 2; ++ai)
#pragma unroll
            for (int m = 0; m < 4; ++m) { int rl = ai * HALF + wr * 64 + m * 16 + fr; asm volatile("" : "+v"(rl));
                f32x4 v[2][2];
#pragma unroll
                for (int bj = 0; bj < 2; ++bj)
#pragma unroll
                    for (int n = 0; n < 2; ++n) v[bj][n] = acc[ai][bj][m][n];
                if (do_rope) { const int t = st0 + rl; const int pos = (wc & 1) ? (t & 63) : (t >> 6);
                    const f32x4 c4 = *(const f32x4*)(ropeC + pos * 16), s4 = *(const f32x4*)(ropeS + pos * 16);
#pragma unroll
                    for (int bj = 0; bj < 2; ++bj) { const f32x4 x1 = v[bj][0], x2 = v[bj][1]; v[bj][0] = x1 * c4 - x2 * s4; v[bj][1] = x2 * c4 + x1 * s4; } }
                if (do_sig) {
#pragma unroll
                    for (int bj = 0; bj < 2; ++bj)
#pragma unroll
                        for (int n = 0; n < 2; ++n)
#pragma unroll
                            for (int i = 0; i < 4; ++i) v[bj][n][i] = __builtin_amdgcn_rcpf(1.0f + __expf(-v[bj][n][i])); }
                bf16_t* rowp = d16 + (size_t)rl * ld16 + wc * 32 + 4 * fq;
#pragma unroll
                for (int bj = 0; bj < 2; ++bj)
#pragma unroll
                    for (int n = 0; n < 2; ++n) *(u32x2*)(rowp + bj * HALF + n * 16) = pack4(v[bj][n]);
                if (d32) { float* rp = d32 + (size_t)rl * 1024 + wc * 32 + 4 * fq;
#pragma unroll
                    for (int bj = 0; bj < 2; ++bj)
#pragma unroll
                        for (int n = 0; n < 2; ++n) *(f32x4*)(rp + bj * HALF + n * 16) = v[bj][n]; }
                asm volatile("" ::: "memory"); }
    }
};

template <class Epi, class Sched, bool ALIGN_EPI = false, bool SP2 = false>
__device__ __forceinline__ void gemm_phase(PG8_LAS unsigned char* lds, const Gemm g, const Sched& S, const Epi& E) {
    int tid_ = threadIdx.x; asm volatile("" : "+v"(tid_));
    const int tid = tid_, wid = __builtin_amdgcn_readfirstlane(tid >> 6), lane = tid & 63, wr = wid >> 2, wc = wid & 3, fr = lane & 15, fq = lane >> 4;
    const int K = g.K, nt = K / BK;
    unsigned voffA[2], voffB[2];
#pragma unroll
    for (int i = 0; i < 2; ++i) { int R, C; stage_rc(tid * 16 + i * 8192, R, C); const int Rb = Epi::PERM ? ((R & ~31) + perm32(R & 31)) : R;
        voffA[i] = (unsigned)(R * K + C) * 2u; voffB[i] = (unsigned)(Rb * K + C) * 2u; }
    const size_t kstep = (size_t)(BK * 2);
    const size_t hstep = (size_t)HALF * K * 2;
    const size_t tstep = 2 * hstep;
    const unsigned ldsw = (unsigned)wid * 1024u;
    const int aoff = lds_byte(wr * 64 + fr, fq * 8), boff = lds_byte(wc * 32 + fr, fq * 8);
#define PG8_SA(b, h) (((b) * 2 + (h)) * HTB)
#define PG8_SB(b, h) ((4 + (b) * 2 + (h)) * HTB)
#define PG8_STAGE(bufoff, gbase, voff) do { _Pragma("unroll") for (int _i = 0; _i < 2; ++_i) \
        __builtin_amdgcn_global_load_lds((const unsigned*)((const char*)(gbase) + (voff)[_i]), (PG8_LAS unsigned*)(lds + (bufoff) + ldsw + _i * 8192), 16, 0, 0); } while (0)
#define PG8_LDA(dst, b, h) do { _Pragma("unroll") for (int m = 0; m < 4; ++m) _Pragma("unroll") for (int k = 0; k < 2; ++k) dst[m][k] = *(const PG8_LAS bf16x8*)(lds + PG8_SA(b, h) + aoff + m * 2048 + k * 1024); } while (0)
#define PG8_LDB(dst, b, h) do { _Pragma("unroll") for (int n = 0; n < 2; ++n) _Pragma("unroll") for (int k = 0; k < 2; ++k) dst[n][k] = *(const PG8_LAS bf16x8*)(lds + PG8_SB(b, h) + boff + n * 2048 + k * 1024); } while (0)
#define PG8_MMA(ai, bj, At, Bt) do { __builtin_amdgcn_s_setprio(1); _Pragma("unroll") for (int m = 0; m < 4; ++m) _Pragma("unroll") for (int n = 0; n < 2; ++n) _Pragma("unroll") for (int k = 0; k < 2; ++k) \
        acc[ai][bj][m][n] = __builtin_amdgcn_mfma_f32_16x16x32_bf16(Bt[n][k], At[m][k], acc[ai][bj][m][n], 0, 0, 0); __builtin_amdgcn_s_setprio(0); } while (0)
#define PG8_WAIT_V(n) asm volatile("s_waitcnt vmcnt(" #n ")" ::: "memory")
#define PG8_WAIT_L(n) asm volatile("s_waitcnt lgkmcnt(" #n ")" ::: "memory")
#define PG8_BAR __builtin_amdgcn_s_barrier()
#define PG8_SCHED __builtin_amdgcn_sched_barrier(0)
    Unit cur, nxt; int ui = 0;
    if (!S.next(0, cur)) return;
    f32x4 acc[2][2][4][2];
#pragma unroll
    for (int a = 0; a < 2; ++a)
#pragma unroll
        for (int b = 0; b < 2; ++b)
#pragma unroll
            for (int m = 0; m < 4; ++m)
#pragma unroll
                for (int n = 0; n < 2; ++n) acc[a][b][m][n] = (f32x4){0.f, 0.f, 0.f, 0.f};
    bf16x8 At[4][2], B0[2][2], B1[2][2];
    const char* cA = (const char*)g.A + (size_t)cur.pm * tstep; const char* cB = (const char*)g.Bt + (size_t)cur.pn * tstep;
    S.a_ready(cur);
    if constexpr (SP2) {
        PG8_STAGE(PG8_SB(0, 0), cB, voffB); PG8_STAGE(PG8_SB(0, 1), cB + hstep, voffB); PG8_STAGE(PG8_SA(0, 0), cA, voffA); PG8_STAGE(PG8_SA(0, 1), cA + hstep, voffA);
        if (wr == 1) PG8_BAR;
        PG8_WAIT_V(2); PG8_BAR;
        PG8_STAGE(PG8_SB(1, 0), cB + kstep, voffB); PG8_STAGE(PG8_SA(1, 0), cA + kstep, voffA); PG8_STAGE(PG8_SB(1, 1), cB + hstep + kstep, voffB);
        PG8_WAIT_V(6); PG8_BAR;
    } else {
        PG8_STAGE(PG8_SB(0, 0), cB, voffB); PG8_STAGE(PG8_SA(0, 0), cA, voffA); PG8_STAGE(PG8_SB(0, 1), cB + hstep, voffB); PG8_STAGE(PG8_SA(0, 1), cA + hstep, voffA);
        if (wr == 1) PG8_BAR;
        PG8_WAIT_V(4); PG8_BAR;
        PG8_STAGE(PG8_SB(1, 0), cB + kstep, voffB); PG8_STAGE(PG8_SA(1, 0), cA + kstep, voffA); PG8_STAGE(PG8_SB(1, 1), cB + hstep + kstep, voffB);
        PG8_WAIT_V(6); PG8_BAR;
    }
    for (;;) {
        const bool has_next = S.next(ui + 1, nxt);
        const char* nA = has_next ? (const char*)g.A + (size_t)nxt.pm * tstep : cA; const char* nB = has_next ? (const char*)g.Bt + (size_t)nxt.pn * tstep : cB;
        for (int t = 0; t < nt; t += 2) {
            const bool last = (t == nt - 2);
            const char* a1 = cA + (size_t)(t + 1) * kstep;
            const char* a2 = last ? nA : cA + (size_t)(t + 2) * kstep; const char* b2 = last ? nB : cB + (size_t)(t + 2) * kstep;
            const char* a3 = a2 + kstep; const char* b3 = b2 + kstep;
            if (last && has_next) S.a_ready(nxt);
            if constexpr (SP2) {
            PG8_LDB(B0, 0, 0); PG8_LDB(B1, 0, 1); PG8_SCHED; PG8_LDA(At, 0, 0); PG8_STAGE(PG8_SA(1, 1), a1 + hstep, voffA);
            PG8_WAIT_V(8); PG8_WAIT_L(0); PG8_BAR; PG8_MMA(0, 0, At, B0); PG8_MMA(0, 1, At, B1); PG8_BAR; PG8_SCHED;
            PG8_LDA(At, 0, 1); PG8_STAGE(PG8_SB(0, 0), b2, voffB); PG8_STAGE(PG8_SB(0, 1), b2 + hstep, voffB); PG8_STAGE(PG8_SA(0, 0), a2, voffA);
            PG8_WAIT_V(8); PG8_WAIT_L(0); PG8_BAR; PG8_MMA(1, 0, At, B0); PG8_MMA(1, 1, At, B1); PG8_BAR; PG8_SCHED;
            PG8_LDB(B0, 1, 0); PG8_LDB(B1, 1, 1); PG8_SCHED; PG8_LDA(At, 1, 0); PG8_STAGE(PG8_SA(0, 1), a2 + hstep, voffA);
            PG8_WAIT_V(8); PG8_WAIT_L(0); PG8_BAR; PG8_MMA(0, 0, At, B0); PG8_MMA(0, 1, At, B1); PG8_BAR; PG8_SCHED;
            PG8_LDA(At, 1, 1); PG8_STAGE(PG8_SB(1, 0), b3, voffB); PG8_STAGE(PG8_SB(1, 1), b3 + hstep, voffB); PG8_STAGE(PG8_SA(1, 0), a3, voffA);
            PG8_WAIT_V(8); PG8_WAIT_L(0); PG8_BAR; PG8_MMA(1, 0, At, B0); PG8_MMA(1, 1, At, B1); PG8_BAR; PG8_SCHED;
            } else {
            PG8_LDB(B0, 0, 0); PG8_SCHED; PG8_LDA(At, 0, 0); PG8_STAGE(PG8_SA(1, 1), a1 + hstep, voffA);
            PG8_WAIT_L(8); PG8_BAR; PG8_WAIT_L(0); PG8_MMA(0, 0, At, B0); PG8_BAR; PG8_SCHED;
            PG8_LDB(B1, 0, 1); PG8_STAGE(PG8_SB(0, 0), b2, voffB);
            PG8_BAR; PG8_WAIT_L(0); PG8_MMA(0, 1, At, B1); PG8_BAR;
            PG8_LDA(At, 0, 1); PG8_STAGE(PG8_SA(0, 0), a2, voffA);
            PG8_BAR; PG8_WAIT_L(0); PG8_MMA(1, 0, At, B0); PG8_BAR; PG8_SCHED;
            PG8_STAGE(PG8_SB(0, 1), b2 + hstep, voffB);
            PG8_WAIT_V(6); PG8_BAR; PG8_MMA(1, 1, At, B1); PG8_BAR;
            PG8_LDB(B0, 1, 0); PG8_SCHED; PG8_LDA(At, 1, 0); PG8_STAGE(PG8_SA(0, 1), a2 + hstep, voffA);
            PG8_WAIT_L(8); PG8_BAR; PG8_WAIT_L(0); PG8_MMA(0, 0, At, B0); PG8_BAR; PG8_SCHED;
            PG8_LDB(B1, 1, 1); PG8_STAGE(PG8_SB(1, 0), b3, voffB);
            PG8_BAR; PG8_WAIT_L(0); PG8_MMA(0, 1, At, B1); PG8_BAR;
            PG8_LDA(At, 1, 1); PG8_STAGE(PG8_SA(1, 0), a3, voffA);
            PG8_BAR; PG8_WAIT_L(0); PG8_MMA(1, 0, At, B0); PG8_BAR; PG8_SCHED;
            PG8_STAGE(PG8_SB(1, 1), b3 + hstep, voffB);
            PG8_WAIT_V(6); PG8_BAR; PG8_MMA(1, 1, At, B1); PG8_BAR;
            }
        }
        if constexpr (ALIGN_EPI) { if (wr == 0) PG8_BAR; }
        if constexpr (!Epi::AFTER_DRAIN) { E(acc, cur, wr, wc, fr, fq); S.done(cur); }
        if (!has_next) break;
#pragma unroll
        for (int a = 0; a < 2; ++a)
#pragma unroll
            for (int b = 0; b < 2; ++b)
#pragma unroll
                for (int m = 0; m < 4; ++m)
#pragma unroll
                    for (int n = 0; n < 2; ++n) acc[a][b][m][n] = (f32x4){0.f, 0.f, 0.f, 0.f};
        cur = nxt; cA = nA; cB = nB; ++ui;
        if constexpr (ALIGN_EPI) { if (wr == 1) PG8_BAR; }
    }
    PG8_WAIT_V(0);
    if constexpr (!ALIGN_EPI) { if (wr == 0) PG8_BAR; }
    PG8_BAR;
    if constexpr (Epi::AFTER_DRAIN) { E.fused(acc, cur, wr, wc, fr, fq, lds, wid, lane); S.done(cur); }
#undef PG8_SA
#undef PG8_SB
#undef PG8_STAGE
#undef PG8_LDA
#undef PG8_LDB
#undef PG8_MMA
#undef PG8_WAIT_V
#undef PG8_WAIT_L
#undef PG8_BAR
#undef PG8_SCHED
}
}

#define GAS __attribute__((address_space(1)))
#define LAS __attribute__((address_space(3)))
typedef unsigned short bf16;
typedef unsigned v4u __attribute__((ext_vector_type(4)));
typedef float f32x4 __attribute__((ext_vector_type(4)));
typedef short bf16x8 __attribute__((ext_vector_type(8)));
typedef GAS unsigned gu32;
typedef GAS unsigned long long gu64;
#define RLX_AGENT __ATOMIC_RELAXED, __HIP_MEMORY_SCOPE_AGENT
#define LDS_WAIT() asm volatile("s_waitcnt lgkmcnt(0)" ::: "memory")
#define VM_WAIT() asm volatile("s_waitcnt vmcnt(0)" ::: "memory")
__device__ __forceinline__ unsigned long long rt() { return __builtin_amdgcn_s_memrealtime(); }
__device__ __forceinline__ unsigned f2bf(float f) { unsigned u = __builtin_bit_cast(unsigned, f); return (u + 0x7fffu + ((u >> 16) & 1u)) >> 16; }
__device__ __forceinline__ unsigned pk2(float lo, float hi) { return f2bf(lo) | (f2bf(hi) << 16); }

#define XB_TMO      128
#define XB_XCNT(j)  (256  + 64 * (j))
#define XB_XSUB(j)  (1280 + 64 * (j))
#define XB_XGEN(j)  (2304 + 64 * (j))
#define XB_TOP      3328
#define XB_TOPGEN   3392
#define XCD_BAR_WORDS 3456
#define XB_SPIN_CAP (1u << 18)

__device__ __forceinline__ unsigned xb_ld(unsigned* p)              { return __hip_atomic_load(p, __ATOMIC_RELAXED, __HIP_MEMORY_SCOPE_AGENT); }
__device__ __forceinline__ unsigned xb_add(unsigned* p, unsigned v) { return __hip_atomic_fetch_add(p, v, __ATOMIC_RELAXED, __HIP_MEMORY_SCOPE_AGENT); }
__device__ __forceinline__ unsigned xb_xcc_id() { return (unsigned)__builtin_amdgcn_s_getreg((3 << 11) | 20) & 0xFu; }
#define XB_SPIN(cond, bar) do { unsigned _sp = 0; while (cond) { __builtin_amdgcn_s_sleep(1); \
    if ((++_sp & 255u) == 0u) { if (xb_ld(&(bar)[XB_TMO])) break; if (_sp > XB_SPIN_CAP) { atomicAdd(&(bar)[XB_TMO], 1u); break; } } } } while (0)

struct XcdBarrier {
    unsigned* bar; unsigned x;
    volatile LAS unsigned* st;
};

__device__ __forceinline__ XcdBarrier xcd_barrier_post(unsigned* bar, volatile LAS unsigned* st) {
    XcdBarrier b; b.bar = bar; b.x = xb_xcc_id(); b.st = st;
    if (threadIdx.x == 0) (void)xb_add(&bar[XB_XCNT(b.x)], 1u);
    return b;
}
__device__ __forceinline__ void xcd_barrier_complete(unsigned* bar, unsigned x, unsigned& nloc, unsigned& nx) {
    const unsigned G = gridDim.x * gridDim.y * gridDim.z;
    unsigned sum, cnt, mine, sp = 0u;
    for (;;) {
        sum = 0u; cnt = 0u; mine = 0u;
#pragma unroll
        for (unsigned j = 0; j < 16; ++j) { const unsigned c = xb_ld(&bar[XB_XCNT(j)]); sum += c; cnt += (c > 0u) ? 1u : 0u; mine = (j == x) ? c : mine; }
        if (sum == G) break;
        __builtin_amdgcn_s_sleep(1);
        if ((++sp & 255u) == 0u) { if (xb_ld(&bar[XB_TMO])) break; if (sp > XB_SPIN_CAP) { atomicAdd(&bar[XB_TMO], 1u); break; } }
    }
    nloc = mine > 0u ? mine : 1u; nx = cnt > 0u ? cnt : 1u;
}

__device__ __forceinline__ void xcd_barrier(const XcdBarrier& b) {
    asm volatile("s_waitcnt vmcnt(0)" ::: "memory");
    __syncthreads();
    if (threadIdx.x == 0) {
        unsigned* bar = b.bar;
        __builtin_amdgcn_s_waitcnt(0);
        unsigned nloc = b.st[0], nx = b.st[1];
        if (nloc == 0u) { xcd_barrier_complete(bar, b.x, nloc, nx); b.st[0] = nloc; b.st[1] = nx; }
        const unsigned old = xb_add(&bar[XB_XSUB(b.x)], 1u);
        const unsigned gen = old / nloc;
        if (old + 1u == (gen + 1u) * nloc) {
            __builtin_amdgcn_fence(__ATOMIC_RELEASE, "agent");
            asm volatile("s_waitcnt vmcnt(0)" ::: "memory");
            const unsigned og = xb_add(&bar[XB_TOP], 1u);
            const unsigned tg = og / nx;
            if (og + 1u == (tg + 1u) * nx) xb_add(&bar[XB_TOPGEN], 1u);
            else XB_SPIN(xb_ld(&bar[XB_TOPGEN]) == tg, bar);
            __builtin_amdgcn_fence(__ATOMIC_ACQUIRE, "agent");
            xb_add(&bar[XB_XGEN(b.x)], 1u);
            asm volatile("s_waitcnt vmcnt(0)" ::: "memory");
        } else {
            XB_SPIN(xb_ld(&bar[XB_XGEN(b.x)]) == gen, bar);
            __builtin_amdgcn_fence(__ATOMIC_ACQUIRE, "agent");
            asm volatile("s_waitcnt vmcnt(0)" ::: "memory");
        }
    }
    __syncthreads();
}

__device__ __forceinline__ float wave_sum(float v) {
#pragma unroll
    for (int o = 1; o < 64; o <<= 1) v += __shfl_xor(v, o);
    return v;
}
__device__ __forceinline__ void p0_transpose_item(const float* W, int K, int N, bf16* WT, int row_off, LAS float* scr, int item, int lane) {
    const int nblk = N / 32, kb = item / nblk, nb = item % nblk, k0 = 64 * kb, n0 = 32 * nb;
#pragma unroll 8
    for (int i = 0; i < 32; ++i) { const int kk = 2 * i + (lane >> 5); scr[kk * 33 + (lane & 31)] = W[(size_t)(k0 + kk) * N + n0 + (lane & 31)]; }
    LDS_WAIT(); asm volatile("" ::: "memory");
    const int c = lane & 7;
#pragma unroll
    for (int j = 0; j < 4; ++j) { const int n = (lane >> 3) + 8 * j; const LAS float* s = scr + (8 * c) * 33 + n;
        v4u o; o.x = pk2(s[0 * 33], s[1 * 33]); o.y = pk2(s[2 * 33], s[3 * 33]); o.z = pk2(s[4 * 33], s[5 * 33]); o.w = pk2(s[6 * 33], s[7 * 33]);
        *(GAS v4u*)(WT + (size_t)(row_off + n0 + n) * K + k0 + 8 * c) = o; }
    LDS_WAIT(); asm volatile("" ::: "memory");
}
struct Args { const float* in[26]; float* out; unsigned char* ws; };
enum { I_XP = 0, I_XS, I_CK, I_CV, I_C, I_CCTX, I_WADA, I_BADA, I_WIN, I_WPOOL, I_PSCALE, I_WPA, I_WPB, I_WOUT, I_LQ1, I_LK1, I_LQ2, I_LK2, I_SUBLN, I_N1, I_N2, I_WFI, I_CONVW, I_CONVB, I_WFO, I_FN };

struct Ctx { LAS unsigned char* lds; int tid, lane, wave, G, bid; };
template <int I> __device__ __forceinline__ unsigned long long karg_raw() {
    unsigned long long v; auto kp = __builtin_amdgcn_kernarg_segment_ptr();
    asm volatile("s_load_dwordx2 %0, %1, %2\n\ts_waitcnt lgkmcnt(0)" : "=s"(v) : "s"(kp), "n"(I * 8) : "memory");
    return v;
}
template <int I> __device__ __forceinline__ const float* karg() { return (const float*)karg_raw<I>(); }
__device__ __forceinline__ float* kout() { return (float*)karg_raw<26>(); }
__device__ __forceinline__ unsigned char* kws() { return (unsigned char*)karg_raw<27>(); }

__device__ __forceinline__ float bf2f(unsigned short b) { return __builtin_bit_cast(float, (unsigned)b << 16); }
__device__ __forceinline__ float bflo(unsigned w) { return __builtin_bit_cast(float, w << 16); }
__device__ __forceinline__ float bfhi(unsigned w) { return __builtin_bit_cast(float, w & 0xffff0000u); }

__device__ __forceinline__ void p0_transposes_a(const Ctx& C) {
    LAS float* scr = (LAS float*)(C.lds + RING_OFF + C.wave * 16384);
    const int gw = C.bid * NWAVES + C.wave, NGW = C.G * NWAVES;
    constexpr int I0 = (1024 / 64) * (5632 / 32), I1 = (512 / 64) * (1024 / 32), I2 = (1024 / 64) * (1024 / 32), I3 = I2;
    unsigned char* ws = kws(); const float* w0 = karg<I_WIN>(); const float* w1 = karg<I_WPA>(); const float* w2 = karg<I_WPB>(); const float* w3 = karg<I_WOUT>();
    for (int it = gw; it < I0 + I1 + I2 + I3; it += NGW) {
        int r = it;
        if (r < I0) { p0_transpose_item(w0, 1024, 5632, (bf16*)(ws + WS_WIN), 0, scr, r, C.lane); continue; } r -= I0;
        if (r < I1) { p0_transpose_item(w1, 512, 1024, (bf16*)(ws + WS_WPA), 0, scr, r, C.lane); continue; } r -= I1;
        if (r < I2) { p0_transpose_item(w2, 1024, 1024, (bf16*)(ws + WS_WPB), 0, scr, r, C.lane); continue; } r -= I2;
        p0_transpose_item(w3, 1024, 1024, (bf16*)(ws + WS_WOUT), 0, scr, r, C.lane);
    }
}
__device__ __forceinline__ void p0_transposes_b(const Ctx& C) {
    LAS float* scr = (LAS float*)(C.lds + RING_OFF + C.wave * 16384);
    const int gw = C.bid * NWAVES + C.wave, NGW = C.G * NWAVES;
    constexpr int I0 = (1024 / 64) * (5632 / 32), I1 = (2816 / 64) * (1024 / 32);
    unsigned char* ws = kws(); const float* w0 = karg<I_WFI>(); const float* w1 = karg<I_WFO>();
    for (int it = gw; it < I0 + I1; it += NGW) {
        int r = it;
        if (r < I0) { p0_transpose_item(w0, 1024, 5632, (bf16*)(ws + WS_WFI), 0, scr, r, C.lane); continue; } r -= I0;
        p0_transpose_item(w1, 2816, 1024, (bf16*)(ws + WS_WFO), 0, scr, r, C.lane);
    }
}
__device__ __forceinline__ void p0_mod(const Ctx& C) {
    if (C.bid >= 96) return;
    const float* cctx = karg<I_CCTX>(); const float* cc = karg<I_C>(); const float* wada = karg<I_WADA>(); const float* bada = karg<I_BADA>();
    LAS float* s = (LAS float*)(C.lds);
    LAS float* red = s + 9 * 1024;
    for (int i = C.tid; i < 9 * 1024; i += 512) { const int r = i >> 10, k = i & 1023; const float v = r == 0 ? cctx[k] : cc[(r - 1) * 1024 + k]; s[i] = v / (1.0f + __expf(-v)); }
    __syncthreads();
    float* mod = (float*)(kws() + WS_MISC);
    for (int it = C.bid; it < 96; it += C.G) {
        const int n = it * 64 + C.lane, k0 = C.wave * 128; float acc[9];
#pragma unroll
        for (int r = 0; r < 9; ++r) acc[r] = 0.f;
        const float* w = wada + (size_t)k0 * 6144 + n;
#pragma unroll 4
        for (int k = 0; k < 128; ++k) { const float wv = w[(size_t)k * 6144];
#pragma unroll
            for (int r = 0; r < 9; ++r) acc[r] += s[r * 1024 + k0 + k] * wv; }
#pragma unroll
        for (int r = 0; r < 9; ++r) red[(C.wave * 9 + r) * 64 + C.lane] = acc[r];
        __syncthreads();
        for (int i = C.tid; i < 576; i += 512) { const int r = i >> 6, c = i & 63; float t = bada[it * 64 + c];
#pragma unroll
            for (int wv = 0; wv < 8; ++wv) t += red[(wv * 9 + r) * 64 + c];
            mod[r * 6144 + it * 64 + c] = t; }
        __syncthreads();
    }
}
__device__ __forceinline__ void p0_misc(const Ctx& C) {
    unsigned char* ws = kws(); const float* ck = karg<I_CK>(); const float* cv = karg<I_CV>();
    const int gt = C.bid * 512 + C.tid, NT = C.G * 512;
    for (int i = gt; i < 2 * 262144; i += NT) {
        const int which = i >= 262144, j = which ? i - 262144 : i; const int row = j >> 7, c8 = (j & 127) * 8;
        const float* src = (which ? cv : ck) + (size_t)row * 1024 + c8;
        const f32x4 x0 = *(const f32x4*)src, x1 = *(const f32x4*)(src + 4);
        v4u o; o.x = pk2(x0[0], x0[1]); o.y = pk2(x0[2], x0[3]); o.z = pk2(x1[0], x1[1]); o.w = pk2(x1[2], x1[3]);
        const int b = row >> 8, t = row & 255;
        *(v4u*)((bf16*)(ws + (which ? WS_VS : WS_KS)) + (size_t)(b * LKV_S + t) * 1024 + c8) = o;
    }
    if (C.bid == C.G - 1) {
        float* rc = (float*)(ws + WS_MISC + MISC_ROPEC); float* rs = (float*)(ws + WS_MISC + MISC_ROPES);
        for (int i = C.tid; i < 1024; i += 512) { const int pos = i >> 4, f = i & 15; const float inv = powf(10000.0f, -(float)f / 16.0f); const float ang = (float)pos * inv; rc[i] = cosf(ang); rs[i] = sinf(ang); }
        if (C.tid == 0) { const float* q1 = karg<I_LQ1>(); const float* k1 = karg<I_LK1>(); const float* q2 = karg<I_LQ2>(); const float* k2 = karg<I_LK2>(); float s1 = 0.f, s2 = 0.f; for (int i = 0; i < 64; ++i) { s1 += q1[i] * k1[i]; s2 += q2[i] * k2[i]; }
            *(float*)(ws + WS_MISC + MISC_LAM) = expf(s1) - expf(s2) + 0.2f; }
    }
}
__device__ __forceinline__ void modulate_rows(const Ctx& C, const float* xp, const float* xs, const float* g, const float* mod, int shift_off, int scale_off, bf16* H) {
    const int gw = C.bid * NWAVES + C.wave, NGW = C.G * NWAVES;
    for (int row = gw; row < MTOK; row += NGW) {
        const float* xr = row < TOK_P ? xp + (size_t)row * DM : xs + (size_t)(row - TOK_P) * DM;
        const float* mr = mod + (row < TOK_P ? 0 : 1 + ((row - TOK_P) >> 11)) * 6144;
        f32x4 v[4]; float ss = 0.f;
#pragma unroll
        for (int j = 0; j < 4; ++j) { v[j] = *(const f32x4*)(xr + 4 * C.lane + 256 * j); ss += (v[j][0] * v[j][0] + v[j][1] * v[j][1]) + (v[j][2] * v[j][2] + v[j][3] * v[j][3]); }
        const float rstd = 1.0f / sqrtf(wave_sum(ss) * (1.0f / DM) + EPS);
#pragma unroll
        for (int j = 0; j < 4; ++j) { const int c = 4 * C.lane + 256 * j; const f32x4 gg = *(const f32x4*)(g + c), sc = *(const f32x4*)(mr + scale_off + c), sh = *(const f32x4*)(mr + shift_off + c);
            const f32x4 o = v[j] * rstd * gg * (sc + 1.0f) + sh;
            unsigned long long w = (unsigned long long)pk2(o[0], o[1]) | ((unsigned long long)pk2(o[2], o[3]) << 32);
            *(unsigned long long*)(H + (size_t)row * DM + c) = w; }
    }
}
__device__ __forceinline__ void final_norm_rows(const Ctx& C, float* X, const float* g) {
    const int gw = C.bid * NWAVES + C.wave, NGW = C.G * NWAVES;
    for (int row = gw; row < MTOK; row += NGW) {
        float* xr = X + (size_t)row * DM; f32x4 v[4]; float ss = 0.f;
#pragma unroll
        for (int j = 0; j < 4; ++j) { v[j] = *(const f32x4*)(xr + 4 * C.lane + 256 * j); ss += (v[j][0] * v[j][0] + v[j][1] * v[j][1]) + (v[j][2] * v[j][2] + v[j][3] * v[j][3]); }
        const float rstd = 1.0f / sqrtf(wave_sum(ss) * (1.0f / DM) + EPS);
#pragma unroll
        for (int j = 0; j < 4; ++j) { const int c = 4 * C.lane + 256 * j; const f32x4 gg = *(const f32x4*)(g + c); *(f32x4*)(xr + c) = v[j] * rstd * gg; }
    }
}

__device__ __forceinline__ void attn_naive(const Ctx& C) {
    unsigned char* ws = kws();
    LAS float* Kt = (LAS float*)(C.lds);
    LAS float* Vt = Kt + 32 * 132;
    const float lam = __hip_atomic_load((float*)(ws + WS_MISC + MISC_LAM), __ATOMIC_RELAXED, __HIP_MEMORY_SCOPE_AGENT);
    const int tid = C.tid, q = tid >> 3, mm = (tid >> 2) & 1, qt = tid & 3;
    bf16* Q = (bf16*)(ws + WS_Q);
    const float* subln = karg<I_SUBLN>();
    for (int it = C.bid; it < 3072; it += C.G) {
        int h, qrow0, nkeys; const bf16 *Kb, *Vb;
        if (it < 2048) { const int b = it >> 8; h = (it >> 5) & 7; const int qb = it & 31; qrow0 = TOK_P + b * SEQ_S + qb * 64; Kb = (const bf16*)(ws + WS_KS) + (size_t)b * LKV_S * 1024; Vb = (const bf16*)(ws + WS_VS) + (size_t)b * LKV_S * 1024; nkeys = LKV_S; }
        else { const int j = it - 2048, b = j >> 5; h = (j >> 2) & 7; const int qb = j & 3; qrow0 = b * SEQ_P + qb * 64; Kb = (const bf16*)(ws + WS_KP) + (size_t)b * SEQ_P * 1024; Vb = (const bf16*)(ws + WS_VP) + (size_t)b * SEQ_P * 1024; nkeys = SEQ_P; }
        float qv[16], o[32];
        { const bf16* qp = Q + (size_t)(qrow0 + q) * 1024 + h * 128 + mm * 64 + qt * 16; const float sc = 0.125f * 1.4426950408889634f;
#pragma unroll
          for (int i = 0; i < 2; ++i) { const v4u r = *(const v4u*)(qp + 8 * i);
              qv[8 * i + 0] = bflo(r.x) * sc; qv[8 * i + 1] = bfhi(r.x) * sc; qv[8 * i + 2] = bflo(r.y) * sc; qv[8 * i + 3] = bfhi(r.y) * sc;
              qv[8 * i + 4] = bflo(r.z) * sc; qv[8 * i + 5] = bfhi(r.z) * sc; qv[8 * i + 6] = bflo(r.w) * sc; qv[8 * i + 7] = bfhi(r.w) * sc; } }
#pragma unroll
        for (int i = 0; i < 32; ++i) o[i] = 0.f;
        float mrun = -1e30f, l = 0.f;
        for (int k0 = 0; k0 < nkeys; k0 += 32) {
            __syncthreads();
            { const int key = tid >> 4, c8 = (tid & 15) * 8;
              const v4u rk = *(const v4u*)(Kb + (size_t)(k0 + key) * 1024 + h * 128 + c8), rv = *(const v4u*)(Vb + (size_t)(k0 + key) * 1024 + h * 128 + c8);
              LAS float* kd = Kt + key * 132 + c8; LAS float* vd = Vt + key * 132 + c8;
              kd[0] = bflo(rk.x); kd[1] = bfhi(rk.x); kd[2] = bflo(rk.y); kd[3] = bfhi(rk.y); kd[4] = bflo(rk.z); kd[5] = bfhi(rk.z); kd[6] = bflo(rk.w); kd[7] = bfhi(rk.w);
              vd[0] = bflo(rv.x); vd[1] = bfhi(rv.x); vd[2] = bflo(rv.y); vd[3] = bfhi(rv.y); vd[4] = bflo(rv.z); vd[5] = bfhi(rv.z); vd[6] = bflo(rv.w); vd[7] = bfhi(rv.w); }
            __syncthreads();
#pragma unroll 1
            for (int kg = 0; kg < 32; kg += 8) {
                float s[8]; float tmax = -1e30f;
#pragma unroll
                for (int key = 0; key < 8; ++key) { const LAS float* kr = Kt + (kg + key) * 132 + mm * 64 + qt * 16; float d = 0.f;
#pragma unroll
                    for (int i = 0; i < 16; i += 4) { const f32x4 kv = *(const LAS f32x4*)(kr + i); d += qv[i] * kv[0] + qv[i + 1] * kv[1] + qv[i + 2] * kv[2] + qv[i + 3] * kv[3]; }
                    d += __shfl_xor(d, 1); d += __shfl_xor(d, 2);
                    s[key] = d; tmax = fmaxf(tmax, d); }
                const float mnew = fmaxf(mrun, tmax), alpha = exp2f(mrun - mnew); mrun = mnew; l *= alpha;
#pragma unroll
                for (int i = 0; i < 32; ++i) o[i] *= alpha;
#pragma unroll
                for (int key = 0; key < 8; ++key) { const float p = exp2f(s[key] - mrun); l += p; const LAS float* vr = Vt + (kg + key) * 132 + qt * 32;
#pragma unroll
                    for (int i = 0; i < 32; i += 4) { const f32x4 vv = *(const LAS f32x4*)(vr + i); o[i] += p * vv[0]; o[i + 1] += p * vv[1]; o[i + 2] += p * vv[2]; o[i + 3] += p * vv[3]; } }
            }
        }
        const float inv = 1.0f / l; float ssq = 0.f;
#pragma unroll
        for (int i = 0; i < 32; ++i) { const float mine = o[i] * inv; const float other = __shfl_xor(mine, 4); o[i] = mine - lam * other; ssq += o[i] * o[i]; }
        ssq += __shfl_xor(ssq, 1); ssq += __shfl_xor(ssq, 2);
        const float r = 0.8f / sqrtf(ssq * (1.0f / 128.0f) + EPS);
        if (mm == 0) { bf16* op = Q + (size_t)(qrow0 + q) * 1024 + h * 128 + qt * 32; const float* sw = subln + qt * 32;
#pragma unroll
            for (int i = 0; i < 32; i += 8) { v4u w; w.x = pk2(o[i] * r * sw[i], o[i + 1] * r * sw[i + 1]); w.y = pk2(o[i + 2] * r * sw[i + 2], o[i + 3] * r * sw[i + 3]);
                w.z = pk2(o[i + 4] * r * sw[i + 4], o[i + 5] * r * sw[i + 5]); w.w = pk2(o[i + 6] * r * sw[i + 6], o[i + 7] * r * sw[i + 7]);
                *(v4u*)(op + i) = w; } }
    }
    __syncthreads();
}
__device__ __forceinline__ void pool_naive(const Ctx& C) {
    unsigned char* ws = kws(); const float* wpool = karg<I_WPOOL>(); const float* pscale = karg<I_PSCALE>();
    LAS float* P = (LAS float*)(C.lds + 65536);
    const bf16* U = (const bf16*)(ws + WS_U); bf16* MX = (bf16*)(ws + WS_MIXED);
    const int tl = C.tid >> 7, e = C.tid & 127;
    for (int it = C.bid; it < MTOK / 4; it += C.G) {
        const int row = it * 4 + tl; int S, t;
        if (row < TOK_P) { S = SEQ_P; t = row & (SEQ_P - 1); } else { S = SEQ_S; t = (row - TOK_P) & (SEQ_S - 1); }
        const int base = row - t;
#pragma unroll
        for (int g = 0; g < 4; ++g) {
            const int hw = 1 << g; const int lo = t - hw < 0 ? 0 : t - hw, hi = t + hw > S ? S : t + hw;
            float sum = 0.f;
            for (int j = lo; j < hi; ++j) sum += bf2f(U[(size_t)(base + j) * DPOOL + g * 128 + e]);
            P[tl * 128 + e] = sum / (float)(hi - lo) - bf2f(U[(size_t)row * DPOOL + g * 128 + e]);
            __syncthreads();
            const float* wp = wpool + (size_t)g * 128 * 128 + e; float acc = 0.f;
#pragma unroll 8
            for (int c = 0; c < 128; ++c) acc += P[tl * 128 + c] * wp[c * 128];
            MX[(size_t)row * DPOOL + g * 128 + e] = (bf16)f2bf(acc * pscale[g * 128 + e]);
            __syncthreads();
        }
    }
}
__device__ __forceinline__ void merge_rows(const Ctx& C) {
    unsigned char* ws = kws();
    const bf16* G = (const bf16*)kout(); const bf16* YA = (const bf16*)(ws + WS_YA); const bf16* YB = (const bf16*)(ws + WS_YB); bf16* MG = (bf16*)(ws + WS_MERGED);
    const int gt = C.bid * 512 + C.tid, NT = C.G * 512;
    for (int i = gt; i < MTOK * 128; i += NT) { const int row = i >> 7, c8 = (i & 127) * 8;
        const v4u ga = *(const v4u*)(G + (size_t)row * 2048 + c8), gb = *(const v4u*)(G + (size_t)row * 2048 + 1024 + c8), ya = *(const v4u*)(YA + (size_t)row * 1024 + c8), yb = *(const v4u*)(YB + (size_t)row * 1024 + c8);
        v4u o;
        o.x = pk2(bflo(ga.x) * bflo(ya.x) + bflo(gb.x) * bflo(yb.x), bfhi(ga.x) * bfhi(ya.x) + bfhi(gb.x) * bfhi(yb.x));
        o.y = pk2(bflo(ga.y) * bflo(ya.y) + bflo(gb.y) * bflo(yb.y), bfhi(ga.y) * bfhi(ya.y) + bfhi(gb.y) * bfhi(yb.y));
        o.z = pk2(bflo(ga.z) * bflo(ya.z) + bflo(gb.z) * bflo(yb.z), bfhi(ga.z) * bfhi(ya.z) + bfhi(gb.z) * bfhi(yb.z));
        o.w = pk2(bflo(ga.w) * bflo(ya.w) + bflo(gb.w) * bflo(yb.w), bfhi(ga.w) * bfhi(ya.w) + bfhi(gb.w) * bfhi(yb.w));
        *(v4u*)(MG + (size_t)row * 1024 + c8) = o; }
}
__device__ __forceinline__ void act_chunk(const Ctx& C, int chunk) {
    unsigned char* ws = kws();
    const bf16* AU = (const bf16*)(ws + WS_AU); bf16* ACT = (bf16*)(ws + WS_ACT);
    const float* cw = karg<I_CONVW>(); const float* cb = karg<I_CONVB>();
    const int S = chunk == 0 ? SEQ_P : SEQ_S;
    const int gt = C.bid * 512 + C.tid, NT = C.G * 512;
    for (int i = gt; i < 8192 * 352; i += NT) { const int row = i / 352, c8 = (i - row * 352) * 8; const int t = row & (S - 1);
        const v4u zero = (v4u){0u, 0u, 0u, 0u};
        const v4u am = t > 0 ? *(const v4u*)(AU + (size_t)(row - 1) * DIN + c8) : zero, a0 = *(const v4u*)(AU + (size_t)row * DIN + c8), ap = t < S - 1 ? *(const v4u*)(AU + (size_t)(row + 1) * DIN + c8) : zero;
        const v4u up = *(const v4u*)(AU + (size_t)row * DIN + DFF + c8);
        float r[8];
#pragma unroll
        for (int j = 0; j < 8; ++j) { const unsigned wm = j < 2 ? am.x : j < 4 ? am.y : j < 6 ? am.z : am.w, w0 = j < 2 ? a0.x : j < 4 ? a0.y : j < 6 ? a0.z : a0.w, wp = j < 2 ? ap.x : j < 4 ? ap.y : j < 6 ? ap.z : ap.w, wu = j < 2 ? up.x : j < 4 ? up.y : j < 6 ? up.z : up.w;
            const float xm = (j & 1) ? bfhi(wm) : bflo(wm), x0 = (j & 1) ? bfhi(w0) : bflo(w0), xp = (j & 1) ? bfhi(wp) : bflo(wp), xu = (j & 1) ? bfhi(wu) : bflo(wu);
            const float cv = cw[c8 + j] * xm + cw[DFF + c8 + j] * x0 + cw[2 * DFF + c8 + j] * xp + cb[c8 + j];
            r[j] = cv / (1.0f + __expf(-cv)) * xu; }
        v4u o; o.x = pk2(r[0], r[1]); o.y = pk2(r[2], r[3]); o.z = pk2(r[4], r[5]); o.w = pk2(r[6], r[7]);
        *(v4u*)(ACT + (size_t)row * DFF + c8) = o; }
}

#ifndef PHASE_MASK
#define PHASE_MASK 0xffffffffu
#endif
#define PH(k) if constexpr (((PHASE_MASK) >> (k)) & 1u)
__global__ void __launch_bounds__(NWAVES * 64, 2) fwd_kernel(Args a_unused) {
    extern __shared__ __attribute__((aligned(16))) unsigned char lds_raw[];
    Ctx C; C.lds = (LAS unsigned char*)lds_raw; C.tid = threadIdx.x; C.lane = C.tid & 63; C.wave = __builtin_amdgcn_readfirstlane(C.tid >> 6); C.G = gridDim.x; C.bid = blockIdx.x;
    volatile LAS unsigned* MISC = (volatile LAS unsigned*)(C.lds + MISC_OFF);
    for (int u = C.tid; u < (LDS_BYTES - LDSCTL_OFF) / 4; u += NWAVES * 64) ((LAS unsigned*)(C.lds + LDSCTL_OFF))[u] = 0u;
    __syncthreads();
    XcdBarrier bar = xcd_barrier_post((unsigned*)(kws() + WS_CTL) + CW_BAR, MISC + 8);
#define GRID_BAR() xcd_barrier(bar)

    PH(0) { p0_transposes_a(C); __syncthreads(); p0_mod(C); __syncthreads(); p0_misc(C); }
    GRID_BAR();
    PH(1) { unsigned char* ws = kws(); modulate_rows(C, karg<I_XP>(), karg<I_XS>(), karg<I_N1>(), (const float*)(ws + WS_MISC), 0, 1024, (bf16*)(ws + WS_H)); }
    GRID_BAR();
    PH(2) { unsigned char* ws = kws(); pg8::Gemm g{(const pg8::bf16_t*)(ws + WS_H), (const pg8::bf16_t*)(ws + WS_WIN), MTOK, DIN, DM}; pg8::StaticOrder S; S.init(MTOK, DIN, C.G, C.bid);
      pg8::EpiProj E{ws, kout()};
      pg8::gemm_phase<pg8::EpiProj, pg8::StaticOrder, true, true>(C.lds + RING_OFF, g, S, E); }
    GRID_BAR();
    PH(3) attn_naive(C);
    PH(4) pool_naive(C);
    GRID_BAR();
    PH(5) { unsigned char* ws = kws(); pg8::Gemm g{(const pg8::bf16_t*)(ws + WS_MIXED), (const pg8::bf16_t*)(ws + WS_WPA), MTOK, DM, DPOOL}; pg8::StaticOrder S; S.init(MTOK, DM, C.G, C.bid);
      pg8::EpiStoreBf16 E{(bf16*)(ws + WS_YA), DM}; pg8::gemm_phase<pg8::EpiStoreBf16, pg8::StaticOrder, true, true>(C.lds + RING_OFF, g, S, E); }
    PH(6) { unsigned char* ws = kws(); pg8::Gemm g{(const pg8::bf16_t*)(ws + WS_Q), (const pg8::bf16_t*)(ws + WS_WPB), MTOK, DM, DM}; pg8::StaticOrder S; S.init(MTOK, DM, C.G, C.bid);
      pg8::EpiStoreBf16 E{(bf16*)(ws + WS_YB), DM}; pg8::gemm_phase<pg8::EpiStoreBf16, pg8::StaticOrder, true, true>(C.lds + RING_OFF, g, S, E); }
    GRID_BAR();
    PH(7) merge_rows(C);
    GRID_BAR();
    PH(8) { unsigned char* ws = kws(); pg8::Gemm g{(const pg8::bf16_t*)(ws + WS_MERGED), (const pg8::bf16_t*)(ws + WS_WOUT), MTOK, DM, DM}; pg8::StaticOrder S; S.init(MTOK, DM, C.G, C.bid);
      pg8::EpiResid E{karg<I_XP>(), karg<I_XS>(), kout(), (const float*)(ws + WS_MISC), 2048, 0}; pg8::gemm_phase<pg8::EpiResid, pg8::StaticOrder, true, true>(C.lds + RING_OFF, g, S, E); }
    GRID_BAR();
    PH(9) { unsigned char* ws = kws(); float* X = kout(); modulate_rows(C, X, X + (size_t)TOK_P * DM, karg<I_N2>(), (const float*)(ws + WS_MISC), 3072, 4096, (bf16*)(ws + WS_H)); __syncthreads(); p0_transposes_b(C); }
    GRID_BAR();
#define FFN_CHUNK(ch) \
    PH(10 + 3 * (ch)) { unsigned char* ws = kws(); pg8::Gemm g{(const pg8::bf16_t*)(ws + WS_H) + (size_t)(ch) * 8192 * DM, (const pg8::bf16_t*)(ws + WS_WFI), 8192, DIN, DM}; pg8::StaticOrder S; S.init(8192, DIN, C.G, C.bid); \
      pg8::EpiStoreBf16 E{(bf16*)(ws + WS_AU), DIN}; pg8::gemm_phase<pg8::EpiStoreBf16, pg8::StaticOrder, true, true>(C.lds + RING_OFF, g, S, E); } \
    GRID_BAR(); \
    PH(11 + 3 * (ch)) act_chunk(C, (ch)); \
    GRID_BAR(); \
    PH(12 + 3 * (ch)) { unsigned char* ws = kws(); float* X = kout(); pg8::Gemm g{(const pg8::bf16_t*)(ws + WS_ACT), (const pg8::bf16_t*)(ws + WS_WFO), 8192, DM, DFF}; pg8::StaticOrder S; S.init(8192, DM, C.G, C.bid); \
      pg8::EpiResid E{X, X + (size_t)TOK_P * DM, X, (const float*)(ws + WS_MISC), 5120, (ch) * 8192}; pg8::gemm_phase<pg8::EpiResid, pg8::StaticOrder, true, true>(C.lds + RING_OFF, g, S, E); }
    FFN_CHUNK(0)
    FFN_CHUNK(1)
    FFN_CHUNK(2)
    GRID_BAR();
    PH(19) final_norm_rows(C, kout(), karg<I_FN>());
}

extern "C" void kernel_launch(void* const* d_in, const int* in_sizes, int n_in, void* d_out, int out_size, void* d_ws, size_t ws_size, hipStream_t stream) {
    static int grid = 0;
    if (grid == 0) {
        if (n_in != 26 || in_sizes[0] != TOK_P * DM || out_size != 41943040 || ws_size < WS_END) { fprintf(stderr, "kernel_launch: unexpected shapes: n_in %d in0 %d out %d ws %zu; nothing launched\n", n_in, n_in > 0 ? in_sizes[0] : -1, out_size, ws_size); grid = -1; return; }
        int dev = 0, cus = 0, per_cu = 0;
        if (hipGetDevice(&dev) != hipSuccess || hipDeviceGetAttribute(&cus, hipDeviceAttributeMultiprocessorCount, dev) != hipSuccess) { grid = -1; return; }
        if (hipFuncSetAttribute((const void*)fwd_kernel, hipFuncAttributeMaxDynamicSharedMemorySize, LDS_BYTES) != hipSuccess) { fprintf(stderr, "kernel_launch: hipFuncSetAttribute failed\n"); grid = -1; return; }
        if (hipOccupancyMaxActiveBlocksPerMultiprocessor(&per_cu, (const void*)fwd_kernel, NWAVES * 64, LDS_BYTES) != hipSuccess || per_cu < 1) fprintf(stderr, "kernel_launch: note: occupancy query reports %d\n", per_cu);
        (void)hipGetLastError();
        grid = cus;
    }
    if (grid < 0) return;
    if (hipMemsetAsync((char*)d_ws + WS_CTL, 0, CTL_ZERO_BYTES, stream) != hipSuccess) return;
    Args a{};
    for (int i = 0; i < 26; ++i) a.in[i] = (const float*)d_in[i];
    a.out = (float*)d_out; a.ws = (unsigned char*)d_ws;
    hipLaunchKernelGGL(fwd_kernel, dim3(grid), dim3(NWAVES * 64), LDS_BYTES, stream, a);
}
```

```cpp
#include <hip/hip_runtime.h>
#include <cstdio>
#include <cstdint>

constexpr int NWAVES = 8;
constexpr int DM = 1024, TOK_P = 8192, TOK_S = 16384, MTOK = 24576, SEQ_P = 256, SEQ_S = 2048, LKV_S = 2304;
constexpr int DIN = 5632, DFF = 2816, DPOOL = 512;
constexpr float EPS = 1e-6f;
constexpr float QSCALE = 0.125f * 1.4426950408889634f;
constexpr size_t MiB = 1u << 20;
constexpr size_t WS_CTL = 0, CTL_ZERO_BYTES = 1 * MiB;
constexpr size_t WS_MISC = 1 * MiB;
constexpr size_t MISC_ROPEC = 256 * 1024, MISC_ROPES = 260 * 1024, MISC_LAM = 320 * 1024;
constexpr size_t WS_WIN = 2 * MiB, WS_WPA = 13 * MiB, WS_WPB = 14 * MiB, WS_WOUT = 16 * MiB;
constexpr size_t WS_H = 18 * MiB;
constexpr size_t WS_U = 66 * MiB;
constexpr size_t WS_Q = 90 * MiB;
constexpr size_t WS_KP = 138 * MiB, WS_KS = 154 * MiB;
constexpr size_t WS_VP = 190 * MiB, WS_VS = 206 * MiB;
constexpr size_t WS_END = 242 * MiB;
constexpr size_t WS_MIXED = WS_H, WS_MERGED = WS_H, WS_YA = WS_KP, WS_YB = WS_VP;
constexpr size_t WS_WFI = WS_U, WS_WFO = WS_U + 11 * MiB;
constexpr size_t WS_AU = WS_Q, WS_ACT = 178 * MiB;
static_assert(WS_AU + (size_t)8192 * 5632 * 2 <= WS_ACT && WS_ACT + (size_t)8192 * 2816 * 2 <= WS_END, "ffn chunk buffers");
constexpr int CW_TMO = 0, CW_CODE = 1, CW_BAR = 4096;
constexpr size_t OUT_K = 25165824, OUT_V = 33554432;
constexpr int RING_OFF = 0, RING_BYTES = 131072;
constexpr int LDSCTL_OFF = RING_BYTES, MISC_OFF = LDSCTL_OFF + 320;
constexpr int LDS_BYTES = 147456;

namespace pg8 {
#define PG8_LAS __attribute__((address_space(3)))
typedef unsigned short bf16_t;
typedef short bf16x8 __attribute__((ext_vector_type(8)));
typedef float f32x4 __attribute__((ext_vector_type(4)));
typedef unsigned u32x4 __attribute__((ext_vector_type(4)));
constexpr int BM = 256, BK = 64, HALF = 128, HTB = HALF * BK * 2  , STAGE_BYTES = 8 * HTB, NXCD = 8, WGM = 8;

__host__ __device__ __forceinline__ int lds_byte(int r, int c) { const int st = (r >> 4) * 2 + (c >> 5), rr = r & 15, cc = c & 31, ob = rr * 64 + cc * 2; return st * 1024 + (ob ^ (((ob >> 9) & 1) << 5)); }
__host__ __device__ __forceinline__ void stage_rc(int b, int& R, int& C) { const int st = b / 1024, sb = b % 1024, swz = sb ^ (((sb >> 9) & 1) << 5); R = (st >> 1) * 16 + swz / 64; C = (st & 1) * 32 + (swz % 64) / 2; }
__host__ __device__ __forceinline__ int perm32(int rho) { const int n = rho >> 4, i = rho & 15; return 8 * (i >> 2) + 4 * n + (i & 3); }

struct Unit { int pm, pn; };
struct Gemm { const bf16_t* A; const bf16_t* Bt; int M, N, K; };

struct StaticOrder {
    int nM, nN, nwg, G, c;
    __host__ __device__ void init(int M, int N, int G_, int c_) { nM = M / BM; nN = N / BM; nwg = nM * nN; G = G_; c = c_; }
    __host__ __device__ bool next(int i, Unit& u) const {
        const long L = (long)i * G + c; if (L >= nwg) return false;
        int wgid = (int)L; { const int q = nwg / NXCD, r = nwg % NXCD, xcd = wgid % NXCD, off = wgid / NXCD; wgid = (xcd < r ? xcd * (q + 1) : r * (q + 1) + (xcd - r) * q) + off; }
        const int nig = WGM * nN, gid = wgid / nig, fm = gid * WGM, gsz = (nM - fm) < WGM ? (nM - fm) : WGM;
        u.pm = fm + ((wgid % nig) % gsz); u.pn = (wgid % nig) / gsz; return true;
    }
    __device__ __forceinline__ void a_ready(const Unit&) const {}
    __device__ __forceinline__ void done(const Unit&) const {}
};


__device__ __forceinline__ unsigned cvt_pk_bf16(float lo, float hi) { unsigned r; asm volatile("v_cvt_pk_bf16_f32 %0, %1, %2" : "=v"(r) : "v"(lo), "v"(hi)); return r; }

typedef unsigned u32x2 __attribute__((ext_vector_type(2)));
__device__ __forceinline__ u32x2 pack4(const f32x4 v) { u32x2 w; w.x = cvt_pk_bf16(v[0], v[1]); w.y = cvt_pk_bf16(v[2], v[3]); return w; }

struct EpiStoreBf16 {
    static constexpr bool PERM = false, AFTER_DRAIN = false;
    bf16_t* O; int ldc;
    __device__ __forceinline__ void operator()(f32x4 (&acc)[2][2][4][2], const Unit& u, int wr, int wc, int fr, int fq) const {
#pragma unroll
        for (int ai = 0; ai < 2; ++ai)
#pragma unroll
            for (int m = 0; m < 4; ++m) { bf16_t* rowp = O + (size_t)(u.pm * BM + ai * HALF + wr * 64 + m * 16 + fr) * ldc + u.pn * BM + wc * 32 + 4 * fq;
#pragma unroll
                for (int bj = 0; bj < 2; ++bj)
#pragma unroll
                    for (int n = 0; n < 2; ++n) *(u32x2*)(rowp + bj * HALF + n * 16) = pack4(acc[ai][bj][m][n]); }
    }
};

struct EpiResid {
    static constexpr bool PERM = false, AFTER_DRAIN = false;
    const float* xin_p; const float* xin_s; float* out; const float* mod; int goff; int row_base;
    __device__ __forceinline__ void operator()(f32x4 (&acc)[2][2][4][2], const Unit& u, int wr, int wc, int fr, int fq) const {
        const int grow0 = row_base + u.pm * BM; const bool smp = grow0 >= 8192;
        const int col0 = u.pn * BM + wc * 32 + 4 * fq;
        const float* xin = (smp ? xin_s + (size_t)(grow0 - 8192) * 1024 : xin_p + (size_t)grow0 * 1024) + col0;
        const float* gate = mod + (smp ? 1 + ((grow0 - 8192) >> 11) : 0) * 6144 + goff + col0;
        float* o = out + (size_t)grow0 * 1024 + col0;
        f32x4 g[2][2];
#pragma unroll
        for (int bj = 0; bj < 2; ++bj)
#pragma unroll
            for (int n = 0; n < 2; ++n) g[bj][n] = *(const f32x4*)(gate + bj * HALF + n * 16);
#pragma unroll
        for (int ai = 0; ai < 2; ++ai)
#pragma unroll
            for (int m = 0; m < 4; ++m) { int rl = ai * HALF + wr * 64 + m * 16 + fr; asm volatile("" : "+v"(rl)); const size_t off = (size_t)rl * 1024;
#pragma unroll
                for (int bj = 0; bj < 2; ++bj)
#pragma unroll
                    for (int n = 0; n < 2; ++n) { const f32x4 x = *(const f32x4*)(xin + off + bj * HALF + n * 16); *(f32x4*)(o + off + bj * HALF + n * 16) = x + g[bj][n] * acc[ai][bj][m][n]; }
                if (m & 1) asm volatile("" ::: "memory"); }
    }
};

struct EpiProj {
    static constexpr bool PERM = false, AFTER_DRAIN = false;
    unsigned char* ws; float* out;
    __device__ __forceinline__ void operator()(f32x4 (&acc)[2][2][4][2], const Unit& u, int wr, int wc, int fr, int fq) const {
        const int pn = u.pn, grow0 = u.pm * BM; const bool smp = u.pm >= 32;
        const int sb = (grow0 - 8192) >> 11, st0 = (grow0 - 8192) & 2047;
        const size_t kvrow = smp ? (size_t)(sb * 2304 + 256 + st0) : (size_t)grow0;
        bf16_t* d16; int ld16; float* d32 = nullptr;
        if (pn < 2)       { d16 = (bf16_t*)(ws + WS_U) + (size_t)grow0 * 512 + pn * BM; ld16 = 512; }
        else if (pn < 6)  { d16 = (bf16_t*)(ws + WS_Q) + (size_t)grow0 * 1024 + (pn - 2) * BM; ld16 = 1024; }
        else if (pn < 10) { d16 = (bf16_t*)(ws + (smp ? WS_KS : WS_KP)) + kvrow * 1024 + (pn - 6) * BM; ld16 = 1024; if (!smp) d32 = out + OUT_K + (size_t)grow0 * 1024 + (pn - 6) * BM; }
        else if (pn < 14) { d16 = (bf16_t*)(ws + (smp ? WS_VS : WS_VP)) + kvrow * 1024 + (pn - 10) * BM; ld16 = 1024; if (!smp) d32 = out + OUT_V + (size_t)grow0 * 1024 + (pn - 10) * BM; }
        else              { d16 = (bf16_t*)out + (size_t)grow0 * 2048 + (pn - 14) * BM; ld16 = 2048; }
        const bool do_rope = smp && pn >= 2 && pn < 10, do_sig = pn >= 14;
        const float* ropeC = (const float*)(ws + WS_MISC + MISC_ROPEC) + 4 * fq; const float* ropeS = (const float*)(ws + WS_MISC + MISC_ROPES) + 4 * fq;
#pragma unroll
        for (int ai = 0; ai < 2; ++ai)
#pragma unroll
            for (int m = 0; m < 4; ++m) { int rl = ai * HALF + wr * 64 + m * 16 + fr; asm volatile("" : "+v"(rl));
                f32x4 v[2][2];
#pragma unroll
                for (int bj = 0; bj < 2; ++bj)
#pragma unroll
                    for (int n = 0; n < 2; ++n) v[bj][n] = acc[ai][bj][m][n];
                if (do_rope) { const int t = st0 + rl; const int pos = (wc & 1) ? (t & 63) : (t >> 6);
                    const f32x4 c4 = *(const f32x4*)(ropeC + pos * 16), s4 = *(const f32x4*)(ropeS + pos * 16);
#pragma unroll
                    for (int bj = 0; bj < 2; ++bj) { const f32x4 x1 = v[bj][0], x2 = v[bj][1]; v[bj][0] = x1 * c4 - x2 * s4; v[bj][1] = x2 * c4 + x1 * s4; } }
                if (pn >= 2 && pn < 6) {
#pragma unroll
                    for (int bj = 0; bj < 2; ++bj)
#pragma unroll
                        for (int n = 0; n < 2; ++n) v[bj][n] = v[bj][n] * QSCALE; }
                if (do_sig) {
#pragma unroll
                    for (int bj = 0; bj < 2; ++bj)
#pragma unroll
                        for (int n = 0; n < 2; ++n)
#pragma unroll
                            for (int i = 0; i < 4; ++i) v[bj][n][i] = __builtin_amdgcn_rcpf(1.0f + __expf(-v[bj][n][i])); }
                bf16_t* rowp = d16 + (size_t)rl * ld16 + wc * 32 + 4 * fq;
#pragma unroll
                for (int bj = 0; bj < 2; ++bj)
#pragma unroll
                    for (int n = 0; n < 2; ++n) *(u32x2*)(rowp + bj * HALF + n * 16) = pack4(v[bj][n]);
                if (d32) { float* rp = d32 + (size_t)rl * 1024 + wc * 32 + 4 * fq;
#pragma unroll
                    for (int bj = 0; bj < 2; ++bj)
#pragma unroll
                        for (int n = 0; n < 2; ++n) *(f32x4*)(rp + bj * HALF + n * 16) = v[bj][n]; }
                asm volatile("" ::: "memory"); }
    }
};

template <class Epi, class Sched, bool ALIGN_EPI = false, bool SP2 = false>
__device__ __forceinline__ void gemm_phase(PG8_LAS unsigned char* lds, const Gemm g, const Sched& S, const Epi& E) {
    int tid_ = threadIdx.x; asm volatile("" : "+v"(tid_));
    const int tid = tid_, wid = __builtin_amdgcn_readfirstlane(tid >> 6), lane = tid & 63, wr = wid >> 2, wc = wid & 3, fr = lane & 15, fq = lane >> 4;
    const int K = g.K, nt = K / BK;
    unsigned voffA[2], voffB[2];
#pragma unroll
    for (int i = 0; i < 2; ++i) { int R, C; stage_rc(tid * 16 + i * 8192, R, C); const int Rb = Epi::PERM ? ((R & ~31) + perm32(R & 31)) : R;
        voffA[i] = (unsigned)(R * K + C) * 2u; voffB[i] = (unsigned)(Rb * K + C) * 2u; }
    const size_t kstep = (size_t)(BK * 2);
    const size_t hstep = (size_t)HALF * K * 2;
    const size_t tstep = 2 * hstep;
    const unsigned ldsw = (unsigned)wid * 1024u;
    const int aoff = lds_byte(wr * 64 + fr, fq * 8), boff = lds_byte(wc * 32 + fr, fq * 8);
#define PG8_SA(b, h) (((b) * 2 + (h)) * HTB)
#define PG8_SB(b, h) ((4 + (b) * 2 + (h)) * HTB)
#define PG8_STAGE(bufoff, gbase, voff) do { _Pragma("unroll") for (int _i = 0; _i < 2; ++_i) \
        __builtin_amdgcn_global_load_lds((const unsigned*)((const char*)(gbase) + (voff)[_i]), (PG8_LAS unsigned*)(lds + (bufoff) + ldsw + _i * 8192), 16, 0, 0); } while (0)
#define PG8_LDA(dst, b, h) do { _Pragma("unroll") for (int m = 0; m < 4; ++m) _Pragma("unroll") for (int k = 0; k < 2; ++k) dst[m][k] = *(const PG8_LAS bf16x8*)(lds + PG8_SA(b, h) + aoff + m * 2048 + k * 1024); } while (0)
#define PG8_LDB(dst, b, h) do { _Pragma("unroll") for (int n = 0; n < 2; ++n) _Pragma("unroll") for (int k = 0; k < 2; ++k) dst[n][k] = *(const PG8_LAS bf16x8*)(lds + PG8_SB(b, h) + boff + n * 2048 + k * 1024); } while (0)
#define PG8_MMA(ai, bj, At, Bt) do { __builtin_amdgcn_s_setprio(1); _Pragma("unroll") for (int m = 0; m < 4; ++m) _Pragma("unroll") for (int n = 0; n < 2; ++n) _Pragma("unroll") for (int k = 0; k < 2; ++k) \
        acc[ai][bj][m][n] = __builtin_amdgcn_mfma_f32_16x16x32_bf16(Bt[n][k], At[m][k], acc[ai][bj][m][n], 0, 0, 0); __builtin_amdgcn_s_setprio(0); } while (0)
#define PG8_WAIT_V(n) asm volatile("s_waitcnt vmcnt(" #n ")" ::: "memory")
#define PG8_WAIT_L(n) asm volatile("s_waitcnt lgkmcnt(" #n ")" ::: "memory")
#define PG8_BAR __builtin_amdgcn_s_barrier()
#define PG8_SCHED __builtin_amdgcn_sched_barrier(0)
    Unit cur, nxt; int ui = 0;
    if (!S.next(0, cur)) return;
    f32x4 acc[2][2][4][2];
#pragma unroll
    for (int a = 0; a < 2; ++a)
#pragma unroll
        for (int b = 0; b < 2; ++b)
#pragma unroll
            for (int m = 0; m < 4; ++m)
#pragma unroll
                for (int n = 0; n < 2; ++n) acc[a][b][m][n] = (f32x4){0.f, 0.f, 0.f, 0.f};
    bf16x8 At[4][2], B0[2][2], B1[2][2];
    const char* cA = (const char*)g.A + (size_t)cur.pm * tstep; const char* cB = (const char*)g.Bt + (size_t)cur.pn * tstep;
    S.a_ready(cur);
    if constexpr (SP2) {
        PG8_STAGE(PG8_SB(0, 0), cB, voffB); PG8_STAGE(PG8_SB(0, 1), cB + hstep, voffB); PG8_STAGE(PG8_SA(0, 0), cA, voffA); PG8_STAGE(PG8_SA(0, 1), cA + hstep, voffA);
        if (wr == 1) PG8_BAR;
        PG8_WAIT_V(2); PG8_BAR;
        PG8_STAGE(PG8_SB(1, 0), cB + kstep, voffB); PG8_STAGE(PG8_SA(1, 0), cA + kstep, voffA); PG8_STAGE(PG8_SB(1, 1), cB + hstep + kstep, voffB);
        PG8_WAIT_V(6); PG8_BAR;
    } else {
        PG8_STAGE(PG8_SB(0, 0), cB, voffB); PG8_STAGE(PG8_SA(0, 0), cA, voffA); PG8_STAGE(PG8_SB(0, 1), cB + hstep, voffB); PG8_STAGE(PG8_SA(0, 1), cA + hstep, voffA);
        if (wr == 1) PG8_BAR;
        PG8_WAIT_V(4); PG8_BAR;
        PG8_STAGE(PG8_SB(1, 0), cB + kstep, voffB); PG8_STAGE(PG8_SA(1, 0), cA + kstep, voffA); PG8_STAGE(PG8_SB(1, 1), cB + hstep + kstep, voffB);
        PG8_WAIT_V(6); PG8_BAR;
    }
    for (;;) {
        const bool has_next = S.next(ui + 1, nxt);
        const char* nA = has_next ? (const char*)g.A + (size_t)nxt.pm * tstep : cA; const char* nB = has_next ? (const char*)g.Bt + (size_t)nxt.pn * tstep : cB;
        for (int t = 0; t < nt; t += 2) {
            const bool last = (t == nt - 2);
            const char* a1 = cA + (size_t)(t + 1) * kstep;
            const char* a2 = last ? nA : cA + (size_t)(t + 2) * kstep; const char* b2 = last ? nB : cB + (size_t)(t + 2) * kstep;
            const char* a3 = a2 + kstep; const char* b3 = b2 + kstep;
            if (last && has_next) S.a_ready(nxt);
            if constexpr (SP2) {
            PG8_LDB(B0, 0, 0); PG8_LDB(B1, 0, 1); PG8_SCHED; PG8_LDA(At, 0, 0); PG8_STAGE(PG8_SA(1, 1), a1 + hstep, voffA);
            PG8_WAIT_V(8); PG8_WAIT_L(0); PG8_BAR; PG8_MMA(0, 0, At, B0); PG8_MMA(0, 1, At, B1); PG8_BAR; PG8_SCHED;
            PG8_LDA(At, 0, 1); PG8_STAGE(PG8_SB(0, 0), b2, voffB); PG8_STAGE(PG8_SB(0, 1), b2 + hstep, voffB); PG8_STAGE(PG8_SA(0, 0), a2, voffA);
            PG8_WAIT_V(8); PG8_WAIT_L(0); PG8_BAR; PG8_MMA(1, 0, At, B0); PG8_MMA(1, 1, At, B1); PG8_BAR; PG8_SCHED;
            PG8_LDB(B0, 1, 0); PG8_LDB(B1, 1, 1); PG8_SCHED; PG8_LDA(At, 1, 0); PG8_STAGE(PG8_SA(0, 1), a2 + hstep, voffA);
            PG8_WAIT_V(8); PG8_WAIT_L(0); PG8_BAR; PG8_MMA(0, 0, At, B0); PG8_MMA(0, 1, At, B1); PG8_BAR; PG8_SCHED;
            PG8_LDA(At, 1, 1); PG8_STAGE(PG8_SB(1, 0), b3, voffB); PG8_STAGE(PG8_SB(1, 1), b3 + hstep, voffB); PG8_STAGE(PG8_SA(1, 0), a3, voffA);
            PG8_WAIT_V(8); PG8_WAIT_L(0); PG8_BAR; PG8_MMA(1, 0, At, B0); PG8_MMA(1, 1, At, B1); PG8_BAR; PG8_SCHED;
            } else {
            PG8_LDB(B0, 0, 0); PG8_SCHED; PG8_LDA(At, 0, 0); PG8_STAGE(PG8_SA(1, 1), a1 + hstep, voffA);
            PG8_WAIT_L(8); PG8_BAR; PG8_WAIT_L(0); PG8_MMA(0, 0, At, B0); PG8_BAR; PG8_SCHED;
            PG8_LDB(B1, 0, 1); PG8_STAGE(PG8_SB(0, 0), b2, voffB);
            PG8_BAR; PG8_WAIT_L(0); PG8_MMA(0, 1, At, B1); PG8_BAR;
            PG8_LDA(At, 0, 1); PG8_STAGE(PG8_SA(0, 0), a2, voffA);
            PG8_BAR; PG8_WAIT_L(0); PG8_MMA(1, 0, At, B0); PG8_BAR; PG8_SCHED;
            PG8_STAGE(PG8_SB(0, 1), b2 + hstep, voffB);
            PG8_WAIT_V(6); PG8_BAR; PG8_MMA(1, 1, At, B1); PG8_BAR;
            PG8_LDB(B0, 1, 0); PG8_SCHED; PG8_LDA(At, 1, 0); PG8_STAGE(PG8_SA(0, 1), a2 + hstep, voffA);
            PG8_WAIT_L(8); PG8_BAR; PG8_WAIT_L(0); PG8_MMA(0, 0, At, B0); PG8_BAR; PG8_SCHED;
            PG8_LDB(B1, 1, 1); PG8_STAGE(PG8_SB(1, 0), b3, voffB);
            PG8_BAR; PG8_WAIT_L(0); PG8_MMA(0, 1, At, B1); PG8_BAR;
            PG8_LDA(At, 1, 1); PG8_STAGE(PG8_SA(1, 0), a3, voffA);
            PG8_BAR; PG8_WAIT_L(0); PG8_MMA(1, 0, At, B0); PG8_BAR; PG8_SCHED;
            PG8_STAGE(PG8_SB(1, 1), b3 + hstep, voffB);
            PG8_WAIT_V(6); PG8_BAR; PG8_MMA(1, 1, At, B1); PG8_BAR;
            }
        }
        if constexpr (ALIGN_EPI) { if (wr == 0) PG8_BAR; }
        if constexpr (!Epi::AFTER_DRAIN) { E(acc, cur, wr, wc, fr, fq); S.done(cur); }
        if (!has_next) break;
#pragma unroll
        for (int a = 0; a < 2; ++a)
#pragma unroll
            for (int b = 0; b < 2; ++b)
#pragma unroll
                for (int m = 0; m < 4; ++m)
#pragma unroll
                    for (int n = 0; n < 2; ++n) acc[a][b][m][n] = (f32x4){0.f, 0.f, 0.f, 0.f};
        cur = nxt; cA = nA; cB = nB; ++ui;
        if constexpr (ALIGN_EPI) { if (wr == 1) PG8_BAR; }
    }
    PG8_WAIT_V(0);
    if constexpr (!ALIGN_EPI) { if (wr == 0) PG8_BAR; }
    PG8_BAR;
    if constexpr (Epi::AFTER_DRAIN) { E.fused(acc, cur, wr, wc, fr, fq, lds, wid, lane); S.done(cur); }
#undef PG8_SA
#undef PG8_SB
#undef PG8_STAGE
#undef PG8_LDA
#undef PG8_LDB
#undef PG8_MMA
#undef PG8_WAIT_V
#undef PG8_WAIT_L
#undef PG8_BAR
#undef PG8_SCHED
}
}

#define GAS __attribute__((address_space(1)))
#define LAS __attribute__((address_space(3)))
typedef unsigned short bf16;
typedef unsigned v4u __attribute__((ext_vector_type(4)));
typedef float f32x4 __attribute__((ext_vector_type(4)));
typedef short bf16x8 __attribute__((ext_vector_type(8)));
typedef GAS unsigned gu32;
typedef GAS unsigned long long gu64;
#define RLX_AGENT __ATOMIC_RELAXED, __HIP_MEMORY_SCOPE_AGENT
#define LDS_WAIT() asm volatile("s_waitcnt lgkmcnt(0)" ::: "memory")
#define VM_WAIT() asm volatile("s_waitcnt vmcnt(0)" ::: "memory")
__device__ __forceinline__ unsigned long long rt() { return __builtin_amdgcn_s_memrealtime(); }
__device__ __forceinline__ unsigned f2bf(float f) { unsigned u = __builtin_bit_cast(unsigned, f); return (u + 0x7fffu + ((u >> 16) & 1u)) >> 16; }
__device__ __forceinline__ unsigned pk2(float lo, float hi) { return f2bf(lo) | (f2bf(hi) << 16); }

#define XB_TMO      128
#define XB_XCNT(j)  (256  + 64 * (j))
#define XB_XSUB(j)  (1280 + 64 * (j))
#define XB_XGEN(j)  (2304 + 64 * (j))
#define XB_TOP      3328
#define XB_TOPGEN   3392
#define XCD_BAR_WORDS 3456
#define XB_SPIN_CAP (1u << 18)

__device__ __forceinline__ unsigned xb_ld(unsigned* p)              { return __hip_atomic_load(p, __ATOMIC_RELAXED, __HIP_MEMORY_SCOPE_AGENT); }
__device__ __forceinline__ unsigned xb_add(unsigned* p, unsigned v) { return __hip_atomic_fetch_add(p, v, __ATOMIC_RELAXED, __HIP_MEMORY_SCOPE_AGENT); }
__device__ __forceinline__ unsigned xb_xcc_id() { return (unsigned)__builtin_amdgcn_s_getreg((3 << 11) | 20) & 0xFu; }
#define XB_SPIN(cond, bar) do { unsigned _sp = 0; while (cond) { __builtin_amdgcn_s_sleep(1); \
    if ((++_sp & 255u) == 0u) { if (xb_ld(&(bar)[XB_TMO])) break; if (_sp > XB_SPIN_CAP) { atomicAdd(&(bar)[XB_TMO], 1u); break; } } } } while (0)

struct XcdBarrier {
    unsigned* bar; unsigned x;
    volatile LAS unsigned* st;
};

__device__ __forceinline__ XcdBarrier xcd_barrier_post(unsigned* bar, volatile LAS unsigned* st) {
    XcdBarrier b; b.bar = bar; b.x = xb_xcc_id(); b.st = st;
    if (threadIdx.x == 0) (void)xb_add(&bar[XB_XCNT(b.x)], 1u);
    return b;
}
__device__ __forceinline__ void xcd_barrier_complete(unsigned* bar, unsigned x, unsigned& nloc, unsigned& nx) {
    const unsigned G = gridDim.x * gridDim.y * gridDim.z;
    unsigned sum, cnt, mine, sp = 0u;
    for (;;) {
        sum = 0u; cnt = 0u; mine = 0u;
#pragma unroll
        for (unsigned j = 0; j < 16; ++j) { const unsigned c = xb_ld(&bar[XB_XCNT(j)]); sum += c; cnt += (c > 0u) ? 1u : 0u; mine = (j == x) ? c : mine; }
        if (sum == G) break;
        __builtin_amdgcn_s_sleep(1);
        if ((++sp & 255u) == 0u) { if (xb_ld(&bar[XB_TMO])) break; if (sp > XB_SPIN_CAP) { atomicAdd(&bar[XB_TMO], 1u); break; } }
    }
    nloc = mine > 0u ? mine : 1u; nx = cnt > 0u ? cnt : 1u;
}

__device__ __forceinline__ void xcd_barrier(const XcdBarrier& b) {
    asm volatile("s_waitcnt vmcnt(0)" ::: "memory");
    __syncthreads();
    if (threadIdx.x == 0) {
        unsigned* bar = b.bar;
        __builtin_amdgcn_s_waitcnt(0);
        unsigned nloc = b.st[0], nx = b.st[1];
        if (nloc == 0u) { xcd_barrier_complete(bar, b.x, nloc, nx); b.st[0] = nloc; b.st[1] = nx; }
        const unsigned old = xb_add(&bar[XB_XSUB(b.x)], 1u);
        const unsigned gen = old / nloc;
        if (old + 1u == (gen + 1u) * nloc) {
            __builtin_amdgcn_fence(__ATOMIC_RELEASE, "agent");
            asm volatile("s_waitcnt vmcnt(0)" ::: "memory");
            const unsigned og = xb_add(&bar[XB_TOP], 1u);
            const unsigned tg = og / nx;
            if (og + 1u == (tg + 1u) * nx) xb_add(&bar[XB_TOPGEN], 1u);
            else XB_SPIN(xb_ld(&bar[XB_TOPGEN]) == tg, bar);
            __builtin_amdgcn_fence(__ATOMIC_ACQUIRE, "agent");
            xb_add(&bar[XB_XGEN(b.x)], 1u);
            asm volatile("s_waitcnt vmcnt(0)" ::: "memory");
        } else {
            XB_SPIN(xb_ld(&bar[XB_XGEN(b.x)]) == gen, bar);
            __builtin_amdgcn_fence(__ATOMIC_ACQUIRE, "agent");
            asm volatile("s_waitcnt vmcnt(0)" ::: "memory");
        }
    }
    __syncthreads();
}

__device__ __forceinline__ float wave_sum(float v) {
#pragma unroll
    for (int o = 1; o < 64; o <<= 1) v += __shfl_xor(v, o);
    return v;
}
__device__ __forceinline__ void p0_transpose_item(const float* W, int K, int N, bf16* WT, int row_off, LAS float* scr, int item, int lane) {
    const int nblk = N / 32, kb = item / nblk, nb = item % nblk, k0 = 64 * kb, n0 = 32 * nb;
#pragma unroll 8
    for (int i = 0; i < 32; ++i) { const int kk = 2 * i + (lane >> 5); scr[kk * 33 + (lane & 31)] = W[(size_t)(k0 + kk) * N + n0 + (lane & 31)]; }
    LDS_WAIT(); asm volatile("" ::: "memory");
    const int c = lane & 7;
#pragma unroll
    for (int j = 0; j < 4; ++j) { const int n = (lane >> 3) + 8 * j; const LAS float* s = scr + (8 * c) * 33 + n;
        v4u o; o.x = pk2(s[0 * 33], s[1 * 33]); o.y = pk2(s[2 * 33], s[3 * 33]); o.z = pk2(s[4 * 33], s[5 * 33]); o.w = pk2(s[6 * 33], s[7 * 33]);
        *(GAS v4u*)(WT + (size_t)(row_off + n0 + n) * K + k0 + 8 * c) = o; }
    LDS_WAIT(); asm volatile("" ::: "memory");
}

namespace att {
using bf16x8 = __attribute__((ext_vector_type(8))) short;
using s16x4 = __attribute__((ext_vector_type(4))) short;
using f32x16 = __attribute__((ext_vector_type(16))) float;
using u32x4 = __attribute__((ext_vector_type(4))) unsigned;
typedef __attribute__((address_space(3))) const char* lds_cptr;
typedef short v4i16_t __attribute__((ext_vector_type(4)));
typedef float f32x2_t __attribute__((ext_vector_type(2))); typedef __bf16 bf16x2_t __attribute__((ext_vector_type(2)));
constexpr int SLOTB = 32768, NSLOT = 3, LDS_WSF = NSLOT * SLOTB, STG = 132;
constexpr float C2 = 0.125f * 1.4426950408889634f;
__device__ __forceinline__ int crow(int r, int hi) { return (r & 3) + 8 * (r >> 2) + 4 * hi; }
__device__ __forceinline__ void glds16(const void* gsrc, unsigned lds_dst) { unsigned keep;
    asm volatile("s_mov_b32 %0, m0\n\ts_mov_b32 m0, %2\n\ts_nop 0\n\tglobal_load_lds_dwordx4 %1, off\n\ts_mov_b32 m0, %0" : "=&s"(keep) : "v"(gsrc), "s"(lds_dst) : "memory"); }
__device__ __forceinline__ unsigned cvtpk_s(float lo, float hi) { f32x2_t v = {lo, hi}; bf16x2_t b = __builtin_convertvector(v, bf16x2_t); return __builtin_bit_cast(unsigned, b); }
__device__ __forceinline__ s16x4 vtr(lds_cptr p) { return __builtin_bit_cast(s16x4, __builtin_amdgcn_ds_read_tr16_b64_v4i16((__attribute__((address_space(3))) v4i16_t*)p)); }
#define ATT_WAIT_BAR(N) asm volatile("s_waitcnt vmcnt(" #N ") lgkmcnt(0)\n\ts_barrier" ::: "memory")
#define ATT_MFMA(a, b, c) __builtin_amdgcn_mfma_f32_32x32x16_bf16((a), (b), (c), 0, 0, 0)

template <int THRL> __device__ __forceinline__ void attn_unit(unsigned short* Qrows, const unsigned short* Kb, const unsigned short* Vb, int NT, int h, float lam, const float* subln, __attribute__((address_space(3))) char* shm) {
    int tid_ = threadIdx.x; asm volatile("" : "+v"(tid_));
    const int tid = tid_, lane = tid & 63, r32 = lane & 31, hi = lane >> 5; const int wid = __builtin_amdgcn_readfirstlane(tid >> 6); const int qb = wid & 3, mp = wid >> 2;
    const unsigned lds0 = (unsigned)(uintptr_t)shm;
    __attribute__((address_space(3))) float* wsf = (__attribute__((address_space(3))) float*)(shm + LDS_WSF) + wid * 64;
    const unsigned short* ksrc = Kb + (size_t)lane * 1024 + h * 128 + wid * 8;
    const unsigned short* vsrc = Vb + (size_t)(16 * (wid & 3) + (lane >> 2)) * 1024 + h * 128 + (wid >> 2) * 32 + (lane & 3) * 8;
    const unsigned kdst = lds0 + wid * 1024, vdst = lds0 + 16384 + wid * 1024;
#define ATT_DMA(t, slot) do { const size_t to_ = (size_t)(t) * 65536; const unsigned so_ = (unsigned)(slot); \
        glds16(ksrc + to_, (unsigned)__builtin_amdgcn_readfirstlane(kdst + so_)); glds16(ksrc + to_ + 64, (unsigned)__builtin_amdgcn_readfirstlane(kdst + 8192 + so_)); \
        glds16(vsrc + to_, (unsigned)__builtin_amdgcn_readfirstlane(vdst + so_)); glds16(vsrc + to_ + 64, (unsigned)__builtin_amdgcn_readfirstlane(vdst + 8192 + so_)); } while (0)
    bf16x8 qr[4];
    { const unsigned short* Qw = Qrows + (size_t)(qb * 32 + r32) * 1024 + h * 128 + mp * 64 + hi * 8;
#pragma unroll
      for (int d0 = 0; d0 < 4; ++d0) qr[d0] = *(const bf16x8*)(Qw + d0 * 16); }
    ATT_DMA(0, 0);
    if (NT > 1) ATT_DMA(1, SLOTB);
    const lds_cptr kp0 = (lds_cptr)shm + mp * 8192 + hi * 1024 + r32 * 16;
    const lds_cptr vp0 = (lds_cptr)shm + 16384 + ((lane >> 4) & 1) * 32 + (lane & 3) * 8 + (4 * hi + ((lane & 15) >> 2)) * 64;
    float mhat = 0.f, l_reg = 0.f; f32x16 o[4]; f32x16 negm;
#pragma unroll
    for (int d = 0; d < 4; ++d) o[d] = f32x16{};
    negm = f32x16{};
    int sl_cur = 0, sl_nn = 2 * SLOTB;
    for (int t = 0; t < NT; ++t) {
        if (t + 1 < NT) ATT_WAIT_BAR(4); else ATT_WAIT_BAR(0);
        if (t + 2 < NT) ATT_DMA(t + 2, sl_nn);
        f32x16 p0, p1;
        { const lds_cptr kp = kp0 + sl_cur;
#pragma unroll
          for (int d0 = 0; d0 < 4; ++d0) { const bf16x8 k0 = *(const __attribute__((address_space(3))) bf16x8*)(kp + d0 * 2048), k1 = *(const __attribute__((address_space(3))) bf16x8*)(kp + d0 * 2048 + 512);
              p0 = ATT_MFMA(k0, qr[d0], d0 == 0 ? negm : p0); p1 = ATT_MFMA(k1, qr[d0], d0 == 0 ? negm : p1); } }
        float rm;
        { float a = fmaxf(fmaxf(p0[0], p0[1]), p1[0]), b = fmaxf(fmaxf(p0[2], p0[3]), p1[1]); a = fmaxf(fmaxf(a, p1[2]), p1[3]);
#pragma unroll
          for (int r = 4; r < 16; r += 4) { a = fmaxf(fmaxf(a, p0[r]), p0[r + 1]); b = fmaxf(fmaxf(b, p0[r + 2]), p0[r + 3]); a = fmaxf(fmaxf(a, p1[r]), p1[r + 1]); b = fmaxf(fmaxf(b, p1[r + 2]), p1[r + 3]); }
          rm = fmaxf(a, b); auto rr = __builtin_amdgcn_permlane32_swap(__float_as_uint(rm), __float_as_uint(rm), false, false); rm = fmaxf(__uint_as_float(rr[0]), __uint_as_float(rr[1])); }
        if (t == 0 || __any(rm > (float)THRL)) {
            const float dl = (t == 0) ? rm : fmaxf(rm, 0.f); mhat += dl;
#pragma unroll
            for (int r = 0; r < 16; ++r) { p0[r] -= dl; p1[r] -= dl; }
#pragma unroll
            for (int r = 0; r < 16; ++r) negm[r] = -mhat;
            if (t > 0) { const float f = __builtin_amdgcn_exp2f(-dl); l_reg *= f; if (hi == 0) wsf[r32] = f;
                float fr_[16];
#pragma unroll
                for (int r = 0; r < 16; ++r) fr_[r] = wsf[crow(r, hi)];
#pragma unroll
                for (int d = 0; d < 4; ++d)
#pragma unroll
                    for (int r = 0; r < 16; ++r) o[d][r] *= fr_[r]; }
        }
        float sacc = 0.f;
#pragma unroll
        for (int r = 0; r < 16; ++r) { p0[r] = __builtin_amdgcn_exp2f(p0[r]); p1[r] = __builtin_amdgcn_exp2f(p1[r]); sacc += p0[r] + p1[r]; }
        l_reg += sacc;
        u32x4 pw[4];
#pragma unroll
        for (int s = 0; s < 2; ++s) { pw[s] = (u32x4){cvtpk_s(p0[8 * s], p0[8 * s + 1]), cvtpk_s(p0[8 * s + 2], p0[8 * s + 3]), cvtpk_s(p0[8 * s + 4], p0[8 * s + 5]), cvtpk_s(p0[8 * s + 6], p0[8 * s + 7])};
            pw[2 + s] = (u32x4){cvtpk_s(p1[8 * s], p1[8 * s + 1]), cvtpk_s(p1[8 * s + 2], p1[8 * s + 3]), cvtpk_s(p1[8 * s + 4], p1[8 * s + 5]), cvtpk_s(p1[8 * s + 6], p1[8 * s + 7])}; }
        { const lds_cptr vp = vp0 + sl_cur;
#pragma unroll
          for (int db = 0; db < 4; ++db) {
#pragma unroll
              for (int ks = 0; ks < 4; ++ks) { const s16x4 lo = vtr(vp + db * 4096 + ks * 1024), hh = vtr(vp + db * 4096 + ks * 1024 + 512);
                  const bf16x8 vf = (bf16x8){lo[0], lo[1], lo[2], lo[3], hh[0], hh[1], hh[2], hh[3]};
                  o[db] = ATT_MFMA(__builtin_bit_cast(bf16x8, pw[ks]), vf, o[db]); } } }
        sl_cur = (sl_cur == 2 * SLOTB) ? 0 : sl_cur + SLOTB; sl_nn = (sl_nn == 2 * SLOTB) ? 0 : sl_nn + SLOTB;
    }
    { auto rr = __builtin_amdgcn_permlane32_swap(__float_as_uint(l_reg), __float_as_uint(l_reg), false, false); l_reg = __uint_as_float(rr[0]) + __uint_as_float(rr[1]); }
    if (hi == 0) wsf[32 + r32] = l_reg;
    { float rli[16];
#pragma unroll
      for (int r = 0; r < 16; ++r) rli[r] = 1.0f / wsf[32 + crow(r, hi)];
#pragma unroll
      for (int d = 0; d < 4; ++d)
#pragma unroll
          for (int r = 0; r < 16; ++r) o[d][r] *= rli[r]; }
    ATT_WAIT_BAR(0);
    __attribute__((address_space(3))) float* stg = (__attribute__((address_space(3))) float*)shm + qb * (32 * STG);
    if (mp == 1) {
#pragma unroll
        for (int d = 0; d < 4; ++d)
#pragma unroll
            for (int r = 0; r < 16; ++r) stg[crow(r, hi) * STG + d * 32 + r32] = o[d][r];
    }
    ATT_WAIT_BAR(0);
    if (mp == 0) {
#pragma unroll
        for (int d = 0; d < 4; ++d)
#pragma unroll
            for (int r = 0; r < 16; ++r) { const int a_ = crow(r, hi) * STG + d * 32 + r32; const float res = o[d][r] - lam * stg[a_]; stg[a_] = res; }
        asm volatile("s_waitcnt lgkmcnt(0)" ::: "memory");
        const __attribute__((address_space(3))) float* rowp = stg + r32 * STG + hi * 64;
        f32x4 v[16]; float ssq = 0.f;
#pragma unroll
        for (int i = 0; i < 16; ++i) { v[i] = *(const __attribute__((address_space(3))) f32x4*)(rowp + 4 * i); ssq += (v[i][0] * v[i][0] + v[i][1] * v[i][1]) + (v[i][2] * v[i][2] + v[i][3] * v[i][3]); }
        { auto rr = __builtin_amdgcn_permlane32_swap(__float_as_uint(ssq), __float_as_uint(ssq), false, false); ssq = __uint_as_float(rr[0]) + __uint_as_float(rr[1]); }
        const float rs = 0.8f / sqrtf(ssq * (1.0f / 128.0f) + 1e-6f);
        unsigned short* op = Qrows + (size_t)(qb * 32 + r32) * 1024 + h * 128 + hi * 64; const float* sw = subln + hi * 64;
#pragma unroll
        for (int i = 0; i < 16; i += 2) { const f32x4 g0 = *(const f32x4*)(sw + 4 * i), g1 = *(const f32x4*)(sw + 4 * i + 4); const f32x4 a = v[i] * g0 * rs, b = v[i + 1] * g1 * rs;
            u32x4 w; w.x = cvtpk_s(a[0], a[1]); w.y = cvtpk_s(a[2], a[3]); w.z = cvtpk_s(b[0], b[1]); w.w = cvtpk_s(b[2], b[3]); *(u32x4*)(op + 4 * i) = w; }
    }
    asm volatile("s_waitcnt vmcnt(0)" ::: "memory");
    ATT_WAIT_BAR(0);
#undef ATT_DMA
}
}

struct Args { const float* in[26]; float* out; unsigned char* ws; };
enum { I_XP = 0, I_XS, I_CK, I_CV, I_C, I_CCTX, I_WADA, I_BADA, I_WIN, I_WPOOL, I_PSCALE, I_WPA, I_WPB, I_WOUT, I_LQ1, I_LK1, I_LQ2, I_LK2, I_SUBLN, I_N1, I_N2, I_WFI, I_CONVW, I_CONVB, I_WFO, I_FN };

struct Ctx { LAS unsigned char* lds; int tid, lane, wave, G, bid; };
template <int I> __device__ __forceinline__ unsigned long long karg_raw() {
    unsigned long long v; auto kp = __builtin_amdgcn_kernarg_segment_ptr();
    asm volatile("s_load_dwordx2 %0, %1, %2\n\ts_waitcnt lgkmcnt(0)" : "=s"(v) : "s"(kp), "n"(I * 8) : "memory");
    return v;
}
template <int I> __device__ __forceinline__ const float* karg() { return (const float*)karg_raw<I>(); }
__device__ __forceinline__ float* kout() { return (float*)karg_raw<26>(); }
__device__ __forceinline__ unsigned char* kws() { return (unsigned char*)karg_raw<27>(); }

__device__ __forceinline__ float bf2f(unsigned short b) { return __builtin_bit_cast(float, (unsigned)b << 16); }
__device__ __forceinline__ float bflo(unsigned w) { return __builtin_bit_cast(float, w << 16); }
__device__ __forceinline__ float bfhi(unsigned w) { return __builtin_bit_cast(float, w & 0xffff0000u); }

__device__ __forceinline__ void p0_transposes_a(const Ctx& C) {
    LAS float* scr = (LAS float*)(C.lds + RING_OFF + C.wave * 16384);
    const int gw = C.bid * NWAVES + C.wave, NGW = C.G * NWAVES;
    constexpr int I0 = (1024 / 64) * (5632 / 32), I1 = (512 / 64) * (1024 / 32), I2 = (1024 / 64) * (1024 / 32), I3 = I2;
    unsigned char* ws = kws(); const float* w0 = karg<I_WIN>(); const float* w1 = karg<I_WPA>(); const float* w2 = karg<I_WPB>(); const float* w3 = karg<I_WOUT>();
    for (int it = gw; it < I0 + I1 + I2 + I3; it += NGW) {
        int r = it;
        if (r < I0) { p0_transpose_item(w0, 1024, 5632, (bf16*)(ws + WS_WIN), 0, scr, r, C.lane); continue; } r -= I0;
        if (r < I1) { p0_transpose_item(w1, 512, 1024, (bf16*)(ws + WS_WPA), 0, scr, r, C.lane); continue; } r -= I1;
        if (r < I2) { p0_transpose_item(w2, 1024, 1024, (bf16*)(ws + WS_WPB), 0, scr, r, C.lane); continue; } r -= I2;
        p0_transpose_item(w3, 1024, 1024, (bf16*)(ws + WS_WOUT), 0, scr, r, C.lane);
    }
}
__device__ __forceinline__ void p0_transposes_b(const Ctx& C) {
    LAS float* scr = (LAS float*)(C.lds + RING_OFF + C.wave * 16384);
    const int gw = C.bid * NWAVES + C.wave, NGW = C.G * NWAVES;
    constexpr int I0 = (1024 / 64) * (5632 / 32), I1 = (2816 / 64) * (1024 / 32);
    unsigned char* ws = kws(); const float* w0 = karg<I_WFI>(); const float* w1 = karg<I_WFO>();
    for (int it = gw; it < I0 + I1; it += NGW) {
        int r = it;
        if (r < I0) { p0_transpose_item(w0, 1024, 5632, (bf16*)(ws + WS_WFI), 0, scr, r, C.lane); continue; } r -= I0;
        p0_transpose_item(w1, 2816, 1024, (bf16*)(ws + WS_WFO), 0, scr, r, C.lane);
    }
}
__device__ __forceinline__ void p0_mod(const Ctx& C) {
    if (C.bid >= 96) return;
    const float* cctx = karg<I_CCTX>(); const float* cc = karg<I_C>(); const float* wada = karg<I_WADA>(); const float* bada = karg<I_BADA>();
    LAS float* s = (LAS float*)(C.lds);
    LAS float* red = s + 9 * 1024;
    for (int i = C.tid; i < 9 * 1024; i += 512) { const int r = i >> 10, k = i & 1023; const float v = r == 0 ? cctx[k] : cc[(r - 1) * 1024 + k]; s[i] = v / (1.0f + __expf(-v)); }
    __syncthreads();
    float* mod = (float*)(kws() + WS_MISC);
    for (int it = C.bid; it < 96; it += C.G) {
        const int n = it * 64 + C.lane, k0 = C.wave * 128; float acc[9];
#pragma unroll
        for (int r = 0; r < 9; ++r) acc[r] = 0.f;
        const float* w = wada + (size_t)k0 * 6144 + n;
#pragma unroll 4
        for (int k = 0; k < 128; ++k) { const float wv = w[(size_t)k * 6144];
#pragma unroll
            for (int r = 0; r < 9; ++r) acc[r] += s[r * 1024 + k0 + k] * wv; }
#pragma unroll
        for (int r = 0; r < 9; ++r) red[(C.wave * 9 + r) * 64 + C.lane] = acc[r];
        __syncthreads();
        for (int i = C.tid; i < 576; i += 512) { const int r = i >> 6, c = i & 63; float t = bada[it * 64 + c];
#pragma unroll
            for (int wv = 0; wv < 8; ++wv) t += red[(wv * 9 + r) * 64 + c];
            mod[r * 6144 + it * 64 + c] = t; }
        __syncthreads();
    }
}
__device__ __forceinline__ void p0_misc(const Ctx& C) {
    unsigned char* ws = kws(); const float* ck = karg<I_CK>(); const float* cv = karg<I_CV>();
    const int gt = C.bid * 512 + C.tid, NT = C.G * 512;
    for (int i = gt; i < 2 * 262144; i += NT) {
        const int which = i >= 262144, j = which ? i - 262144 : i; const int row = j >> 7, c8 = (j & 127) * 8;
        const float* src = (which ? cv : ck) + (size_t)row * 1024 + c8;
        const f32x4 x0 = *(const f32x4*)src, x1 = *(const f32x4*)(src + 4);
        v4u o; o.x = pk2(x0[0], x0[1]); o.y = pk2(x0[2], x0[3]); o.z = pk2(x1[0], x1[1]); o.w = pk2(x1[2], x1[3]);
        const int b = row >> 8, t = row & 255;
        *(v4u*)((bf16*)(ws + (which ? WS_VS : WS_KS)) + (size_t)(b * LKV_S + t) * 1024 + c8) = o;
    }
    if (C.bid == C.G - 1) {
        float* rc = (float*)(ws + WS_MISC + MISC_ROPEC); float* rs = (float*)(ws + WS_MISC + MISC_ROPES);
        for (int i = C.tid; i < 1024; i += 512) { const int pos = i >> 4, f = i & 15; const float inv = powf(10000.0f, -(float)f / 16.0f); const float ang = (float)pos * inv; rc[i] = cosf(ang); rs[i] = sinf(ang); }
        if (C.tid == 0) { const float* q1 = karg<I_LQ1>(); const float* k1 = karg<I_LK1>(); const float* q2 = karg<I_LQ2>(); const float* k2 = karg<I_LK2>(); float s1 = 0.f, s2 = 0.f; for (int i = 0; i < 64; ++i) { s1 += q1[i] * k1[i]; s2 += q2[i] * k2[i]; }
            *(float*)(ws + WS_MISC + MISC_LAM) = expf(s1) - expf(s2) + 0.2f; }
    }
}
__device__ __forceinline__ void modulate_rows(const Ctx& C, const float* xp, const float* xs, const float* g, const float* mod, int shift_off, int scale_off, bf16* H) {
    const int gw = C.bid * NWAVES + C.wave, NGW = C.G * NWAVES;
    for (int row = gw; row < MTOK; row += NGW) {
        const float* xr = row < TOK_P ? xp + (size_t)row * DM : xs + (size_t)(row - TOK_P) * DM;
        const float* mr = mod + (row < TOK_P ? 0 : 1 + ((row - TOK_P) >> 11)) * 6144;
        f32x4 v[4]; float ss = 0.f;
#pragma unroll
        for (int j = 0; j < 4; ++j) { v[j] = *(const f32x4*)(xr + 4 * C.lane + 256 * j); ss += (v[j][0] * v[j][0] + v[j][1] * v[j][1]) + (v[j][2] * v[j][2] + v[j][3] * v[j][3]); }
        const float rstd = 1.0f / sqrtf(wave_sum(ss) * (1.0f / DM) + EPS);
#pragma unroll
        for (int j = 0; j < 4; ++j) { const int c = 4 * C.lane + 256 * j; const f32x4 gg = *(const f32x4*)(g + c), sc = *(const f32x4*)(mr + scale_off + c), sh = *(const f32x4*)(mr + shift_off + c);
            const f32x4 o = v[j] * rstd * gg * (sc + 1.0f) + sh;
            unsigned long long w = (unsigned long long)pk2(o[0], o[1]) | ((unsigned long long)pk2(o[2], o[3]) << 32);
            *(unsigned long long*)(H + (size_t)row * DM + c) = w; }
    }
}
__device__ __forceinline__ void final_norm_rows(const Ctx& C, float* X, const float* g) {
    const int gw = C.bid * NWAVES + C.wave, NGW = C.G * NWAVES;
    for (int row = gw; row < MTOK; row += NGW) {
        float* xr = X + (size_t)row * DM; f32x4 v[4]; float ss = 0.f;
#pragma unroll
        for (int j = 0; j < 4; ++j) { v[j] = *(const f32x4*)(xr + 4 * C.lane + 256 * j); ss += (v[j][0] * v[j][0] + v[j][1] * v[j][1]) + (v[j][2] * v[j][2] + v[j][3] * v[j][3]); }
        const float rstd = 1.0f / sqrtf(wave_sum(ss) * (1.0f / DM) + EPS);
#pragma unroll
        for (int j = 0; j < 4; ++j) { const int c = 4 * C.lane + 256 * j; const f32x4 gg = *(const f32x4*)(g + c); *(f32x4*)(xr + c) = v[j] * rstd * gg; }
    }
}

__device__ __forceinline__ void attn_phase(const Ctx& C) {
    unsigned char* ws = kws(); const float* subln = karg<I_SUBLN>();
    const float lam = __hip_atomic_load((float*)(ws + WS_MISC + MISC_LAM), __ATOMIC_RELAXED, __HIP_MEMORY_SCOPE_AGENT);
    const int vcu = (C.G % 8 == 0) ? (C.bid % 8) * (C.G / 8) + C.bid / 8 : C.bid;
    bf16* Q = (bf16*)(ws + WS_Q);
    for (int u = vcu; u < 1536; u += C.G) {
        bf16* Qrows; const bf16 *Kb, *Vb; int NT, h;
        if (u < 1024) { const int i = u >> 8, v = u & 255, x = v >> 5, c = v & 31, bh = x * 8 + i * 2 + (c >> 4), b = bh >> 3; h = bh & 7;
            Qrows = Q + (size_t)(TOK_P + b * SEQ_S + (c & 15) * 128) * 1024; Kb = (const bf16*)(ws + WS_KS) + (size_t)b * LKV_S * 1024; Vb = (const bf16*)(ws + WS_VS) + (size_t)b * LKV_S * 1024; NT = LKV_S / 64; }
        else { const int j = u - 1024, bh = j >> 1, b = bh >> 3; h = bh & 7;
            Qrows = Q + (size_t)(b * SEQ_P + (j & 1) * 128) * 1024; Kb = (const bf16*)(ws + WS_KP) + (size_t)b * SEQ_P * 1024; Vb = (const bf16*)(ws + WS_VP) + (size_t)b * SEQ_P * 1024; NT = SEQ_P / 64; }
        att::attn_unit<8>(Qrows, Kb, Vb, NT, h, lam, subln, (__attribute__((address_space(3))) char*)C.lds);
    }
}
__device__ __forceinline__ void pool_naive(const Ctx& C) {
    unsigned char* ws = kws(); const float* wpool = karg<I_WPOOL>(); const float* pscale = karg<I_PSCALE>();
    LAS float* P = (LAS float*)(C.lds + 65536);
    const bf16* U = (const bf16*)(ws + WS_U); bf16* MX = (bf16*)(ws + WS_MIXED);
    const int tl = C.tid >> 7, e = C.tid & 127;
    for (int it = C.bid; it < MTOK / 4; it += C.G) {
        const int row = it * 4 + tl; int S, t;
        if (row < TOK_P) { S = SEQ_P; t = row & (SEQ_P - 1); } else { S = SEQ_S; t = (row - TOK_P) & (SEQ_S - 1); }
        const int base = row - t;
#pragma unroll
        for (int g = 0; g < 4; ++g) {
            const int hw = 1 << g; const int lo = t - hw < 0 ? 0 : t - hw, hi = t + hw > S ? S : t + hw;
            float sum = 0.f;
            for (int j = lo; j < hi; ++j) sum += bf2f(U[(size_t)(base + j) * DPOOL + g * 128 + e]);
            P[tl * 128 + e] = sum / (float)(hi - lo) - bf2f(U[(size_t)row * DPOOL + g * 128 + e]);
            __syncthreads();
            const float* wp = wpool + (size_t)g * 128 * 128 + e; float acc = 0.f;
#pragma unroll 8
            for (int c = 0; c < 128; ++c) acc += P[tl * 128 + c] * wp[c * 128];
            MX[(size_t)row * DPOOL + g * 128 + e] = (bf16)f2bf(acc * pscale[g * 128 + e]);
            __syncthreads();
        }
    }
}
__device__ __forceinline__ void merge_rows(const Ctx& C) {
    unsigned char* ws = kws();
    const bf16* G = (const bf16*)kout(); const bf16* YA = (const bf16*)(ws + WS_YA); const bf16* YB = (const bf16*)(ws + WS_YB); bf16* MG = (bf16*)(ws + WS_MERGED);
    const int gt = C.bid * 512 + C.tid, NT = C.G * 512;
    for (int i = gt; i < MTOK * 128; i += NT) { const int row = i >> 7, c8 = (i & 127) * 8;
        const v4u ga = *(const v4u*)(G + (size_t)row * 2048 + c8), gb = *(const v4u*)(G + (size_t)row * 2048 + 1024 + c8), ya = *(const v4u*)(YA + (size_t)row * 1024 + c8), yb = *(const v4u*)(YB + (size_t)row * 1024 + c8);
        v4u o;
        o.x = pk2(bflo(ga.x) * bflo(ya.x) + bflo(gb.x) * bflo(yb.x), bfhi(ga.x) * bfhi(ya.x) + bfhi(gb.x) * bfhi(yb.x));
        o.y = pk2(bflo(ga.y) * bflo(ya.y) + bflo(gb.y) * bflo(yb.y), bfhi(ga.y) * bfhi(ya.y) + bfhi(gb.y) * bfhi(yb.y));
        o.z = pk2(bflo(ga.z) * bflo(ya.z) + bflo(gb.z) * bflo(yb.z), bfhi(ga.z) * bfhi(ya.z) + bfhi(gb.z) * bfhi(yb.z));
        o.w = pk2(bflo(ga.w) * bflo(ya.w) + bflo(gb.w) * bflo(yb.w), bfhi(ga.w) * bfhi(ya.w) + bfhi(gb.w) * bfhi(yb.w));
        *(v4u*)(MG + (size_t)row * 1024 + c8) = o; }
}
__device__ __forceinline__ void act_chunk(const Ctx& C, int chunk) {
    unsigned char* ws = kws();
    const bf16* AU = (const bf16*)(ws + WS_AU); bf16* ACT = (bf16*)(ws + WS_ACT);
    const float* cw = karg<I_CONVW>(); const float* cb = karg<I_CONVB>();
    const int S = chunk == 0 ? SEQ_P : SEQ_S;
    const int gt = C.bid * 512 + C.tid, NT = C.G * 512;
    for (int i = gt; i < 8192 * 352; i += NT) { const int row = i / 352, c8 = (i - row * 352) * 8; const int t = row & (S - 1);
        const v4u zero = (v4u){0u, 0u, 0u, 0u};
        const v4u am = t > 0 ? *(const v4u*)(AU + (size_t)(row - 1) * DIN + c8) : zero, a0 = *(const v4u*)(AU + (size_t)row * DIN + c8), ap = t < S - 1 ? *(const v4u*)(AU + (size_t)(row + 1) * DIN + c8) : zero;
        const v4u up = *(const v4u*)(AU + (size_t)row * DIN + DFF + c8);
        float r[8];
#pragma unroll
        for (int j = 0; j < 8; ++j) { const unsigned wm = j < 2 ? am.x : j < 4 ? am.y : j < 6 ? am.z : am.w, w0 = j < 2 ? a0.x : j < 4 ? a0.y : j < 6 ? a0.z : a0.w, wp = j < 2 ? ap.x : j < 4 ? ap.y : j < 6 ? ap.z : ap.w, wu = j < 2 ? up.x : j < 4 ? up.y : j < 6 ? up.z : up.w;
            const float xm = (j & 1) ? bfhi(wm) : bflo(wm), x0 = (j & 1) ? bfhi(w0) : bflo(w0), xp = (j & 1) ? bfhi(wp) : bflo(wp), xu = (j & 1) ? bfhi(wu) : bflo(wu);
            const float cv = cw[c8 + j] * xm + cw[DFF + c8 + j] * x0 + cw[2 * DFF + c8 + j] * xp + cb[c8 + j];
            r[j] = cv / (1.0f + __expf(-cv)) * xu; }
        v4u o; o.x = pk2(r[0], r[1]); o.y = pk2(r[2], r[3]); o.z = pk2(r[4], r[5]); o.w = pk2(r[6], r[7]);
        *(v4u*)(ACT + (size_t)row * DFF + c8) = o; }
}

#ifndef PHASE_MASK
#define PHASE_MASK 0xffffffffu
#endif
#define PH(k) if constexpr (((PHASE_MASK) >> (k)) & 1u)
__global__ void __launch_bounds__(NWAVES * 64, 2) fwd_kernel(Args a_unused) {
    extern __shared__ __attribute__((aligned(16))) unsigned char lds_raw[];
    Ctx C; C.lds = (LAS unsigned char*)lds_raw; C.tid = threadIdx.x; C.lane = C.tid & 63; C.wave = __builtin_amdgcn_readfirstlane(C.tid >> 6); C.G = gridDim.x; C.bid = blockIdx.x;
    volatile LAS unsigned* MISC = (volatile LAS unsigned*)(C.lds + MISC_OFF);
    for (int u = C.tid; u < (LDS_BYTES - LDSCTL_OFF) / 4; u += NWAVES * 64) ((LAS unsigned*)(C.lds + LDSCTL_OFF))[u] = 0u;
    __syncthreads();
    XcdBarrier bar = xcd_barrier_post((unsigned*)(kws() + WS_CTL) + CW_BAR, MISC + 8);
#define GRID_BAR() xcd_barrier(bar)

    PH(0) { p0_transposes_a(C); __syncthreads(); p0_mod(C); __syncthreads(); p0_misc(C); }
    GRID_BAR();
    PH(1) { unsigned char* ws = kws(); modulate_rows(C, karg<I_XP>(), karg<I_XS>(), karg<I_N1>(), (const float*)(ws + WS_MISC), 0, 1024, (bf16*)(ws + WS_H)); }
    GRID_BAR();
    PH(2) { unsigned char* ws = kws(); pg8::Gemm g{(const pg8::bf16_t*)(ws + WS_H), (const pg8::bf16_t*)(ws + WS_WIN), MTOK, DIN, DM}; pg8::StaticOrder S; S.init(MTOK, DIN, C.G, C.bid);
      pg8::EpiProj E{ws, kout()};
      pg8::gemm_phase<pg8::EpiProj, pg8::StaticOrder, true, true>(C.lds + RING_OFF, g, S, E); }
    GRID_BAR();
    PH(3) attn_phase(C);
    PH(4) pool_naive(C);
    GRID_BAR();
    PH(5) { unsigned char* ws = kws(); pg8::Gemm g{(const pg8::bf16_t*)(ws + WS_MIXED), (const pg8::bf16_t*)(ws + WS_WPA), MTOK, DM, DPOOL}; pg8::StaticOrder S; S.init(MTOK, DM, C.G, C.bid);
      pg8::EpiStoreBf16 E{(bf16*)(ws + WS_YA), DM}; pg8::gemm_phase<pg8::EpiStoreBf16, pg8::StaticOrder, true, true>(C.lds + RING_OFF, g, S, E); }
    PH(6) { unsigned char* ws = kws(); pg8::Gemm g{(const pg8::bf16_t*)(ws + WS_Q), (const pg8::bf16_t*)(ws + WS_WPB), MTOK, DM, DM}; pg8::StaticOrder S; S.init(MTOK, DM, C.G, C.bid);
      pg8::EpiStoreBf16 E{(bf16*)(ws + WS_YB), DM}; pg8::gemm_phase<pg8::EpiStoreBf16, pg8::StaticOrder, true, true>(C.lds + RING_OFF, g, S, E); }
    GRID_BAR();
    PH(7) merge_rows(C);
    GRID_BAR();
    PH(8) { unsigned char* ws = kws(); pg8::Gemm g{(const pg8::bf16_t*)(ws + WS_MERGED), (const pg8::bf16_t*)(ws + WS_WOUT), MTOK, DM, DM}; pg8::StaticOrder S; S.init(MTOK, DM, C.G, C.bid);
      pg8::EpiResid E{karg<I_XP>(), karg<I_XS>(), kout(), (const float*)(ws + WS_MISC), 2048, 0}; pg8::gemm_phase<pg8::EpiResid, pg8::StaticOrder, true, true>(C.lds + RING_OFF, g, S, E); }
    GRID_BAR();
    PH(9) { unsigned char* ws = kws(); float* X = kout(); modulate_rows(C, X, X + (size_t)TOK_P * DM, karg<I_N2>(), (const float*)(ws + WS_MISC), 3072, 4096, (bf16*)(ws + WS_H)); __syncthreads(); p0_transposes_b(C); }
    GRID_BAR();
#define FFN_CHUNK(ch) \
    PH(10 + 3 * (ch)) { unsigned char* ws = kws(); pg8::Gemm g{(const pg8::bf16_t*)(ws + WS_H) + (size_t)(ch) * 8192 * DM, (const pg8::bf16_t*)(ws + WS_WFI), 8192, DIN, DM}; pg8::StaticOrder S; S.init(8192, DIN, C.G, C.bid); \
      pg8::EpiStoreBf16 E{(bf16*)(ws + WS_AU), DIN}; pg8::gemm_phase<pg8::EpiStoreBf16, pg8::StaticOrder, true, true>(C.lds + RING_OFF, g, S, E); } \
    GRID_BAR(); \
    PH(11 + 3 * (ch)) act_chunk(C, (ch)); \
    GRID_BAR(); \
    PH(12 + 3 * (ch)) { unsigned char* ws = kws(); float* X = kout(); pg8::Gemm g{(const pg8::bf16_t*)(ws + WS_ACT), (const pg8::bf16_t*)(ws + WS_WFO), 8192, DM, DFF}; pg8::StaticOrder S; S.init(8192, DM, C.G, C.bid); \
      pg8::EpiResid E{X, X + (size_t)TOK_P * DM, X, (const float*)(ws + WS_MISC), 5120, (ch) * 8192}; pg8::gemm_phase<pg8::EpiResid, pg8::StaticOrder, true, true>(C.lds + RING_OFF, g, S, E); }
    FFN_CHUNK(0)
    FFN_CHUNK(1)
    FFN_CHUNK(2)
    GRID_BAR();
    PH(19) final_norm_rows(C, kout(), karg<I_FN>());
}

extern "C" void kernel_launch(void* const* d_in, const int* in_sizes, int n_in, void* d_out, int out_size, void* d_ws, size_t ws_size, hipStream_t stream) {
    static int grid = 0;
    if (grid == 0) {
        if (n_in != 26 || in_sizes[0] != TOK_P * DM || out_size != 41943040 || ws_size < WS_END) { fprintf(stderr, "kernel_launch: unexpected shapes: n_in %d in0 %d out %d ws %zu; nothing launched\n", n_in, n_in > 0 ? in_sizes[0] : -1, out_size, ws_size); grid = -1; return; }
        int dev = 0, cus = 0, per_cu = 0;
        if (hipGetDevice(&dev) != hipSuccess || hipDeviceGetAttribute(&cus, hipDeviceAttributeMultiprocessorCount, dev) != hipSuccess) { grid = -1; return; }
        if (hipFuncSetAttribute((const void*)fwd_kernel, hipFuncAttributeMaxDynamicSharedMemorySize, LDS_BYTES) != hipSuccess) { fprintf(stderr, "kernel_launch: hipFuncSetAttribute failed\n"); grid = -1; return; }
        if (hipOccupancyMaxActiveBlocksPerMultiprocessor(&per_cu, (const void*)fwd_kernel, NWAVES * 64, LDS_BYTES) != hipSuccess || per_cu < 1) fprintf(stderr, "kernel_launch: note: occupancy query reports %d\n", per_cu);
        (void)hipGetLastError();
        grid = cus;
    }
    if (grid < 0) return;
    if (hipMemsetAsync((char*)d_ws + WS_CTL, 0, CTL_ZERO_BYTES, stream) != hipSuccess) return;
    Args a{};
    for (int i = 0; i < 26; ++i) a.in[i] = (const float*)d_in[i];
    a.out = (float*)d_out; a.ws = (unsigned char*)d_ws;
    hipLaunchKernelGGL(fwd_kernel, dim3(grid), dim3(NWAVES * 64), LDS_BYTES, stream, a);
}
```

```cpp
#include <hip/hip_runtime.h>
#include <cstdio>
#include <cstdint>

constexpr int NWAVES = 8;
constexpr int DM = 1024, TOK_P = 8192, TOK_S = 16384, MTOK = 24576, SEQ_P = 256, SEQ_S = 2048, LKV_S = 2304;
constexpr int DIN = 5632, DFF = 2816, DPOOL = 512;
constexpr float EPS = 1e-6f;
constexpr float QSCALE = 0.125f * 1.4426950408889634f;
constexpr size_t MiB = 1u << 20;
constexpr size_t WS_CTL = 0, CTL_ZERO_BYTES = 1 * MiB;
constexpr size_t WS_MISC = 1 * MiB;
constexpr size_t MISC_ROPEC = 256 * 1024, MISC_ROPES = 260 * 1024, MISC_LAM = 320 * 1024;
constexpr size_t WS_WIN = 2 * MiB, WS_WPA = 13 * MiB, WS_WPB = 14 * MiB, WS_WOUT = 16 * MiB;
constexpr size_t WS_H = 18 * MiB;
constexpr size_t WS_U = 66 * MiB;
constexpr size_t WS_Q = 90 * MiB;
constexpr size_t WS_KP = 138 * MiB, WS_KS = 154 * MiB;
constexpr size_t WS_VP = 190 * MiB, WS_VS = 206 * MiB;
constexpr size_t WS_END = 242 * MiB;
constexpr size_t WS_MIXED = WS_H, WS_POOLED = WS_H + 24 * MiB, WS_MERGED = WS_KP;
constexpr size_t WS_WPOOLT = WS_MISC + 512 * 1024;
constexpr size_t WS_WFI = WS_U, WS_WFO = WS_U + 11 * MiB;
constexpr size_t WS_ACT = WS_Q, WS_SIDE = 222 * MiB;
static_assert(WS_ACT + (size_t)24576 * 2816 * 2 <= WS_SIDE && WS_SIDE + (size_t)96 * 22 * 6 * 128 * 4 <= WS_END, "ffn buffers");
constexpr int CW_TMO = 0, CW_CODE = 1, CW_BAR = 4096;
constexpr size_t OUT_K = 25165824, OUT_V = 33554432;
constexpr int RING_OFF = 0, RING_BYTES = 131072;
constexpr int LDSCTL_OFF = RING_BYTES, MISC_OFF = LDSCTL_OFF + 320;
constexpr int LDS_EDGE_OFF = LDSCTL_OFF + 1024;
constexpr int LDS_BYTES = 147456;

namespace pg8 {
#define PG8_LAS __attribute__((address_space(3)))
typedef unsigned short bf16_t;
typedef short bf16x8 __attribute__((ext_vector_type(8)));
typedef float f32x4 __attribute__((ext_vector_type(4)));
typedef unsigned u32x4 __attribute__((ext_vector_type(4)));
constexpr int BM = 256, BK = 64, HALF = 128, HTB = HALF * BK * 2  , STAGE_BYTES = 8 * HTB, NXCD = 8, WGM = 8;

__host__ __device__ __forceinline__ int lds_byte(int r, int c) { const int st = (r >> 4) * 2 + (c >> 5), rr = r & 15, cc = c & 31, ob = rr * 64 + cc * 2; return st * 1024 + (ob ^ (((ob >> 9) & 1) << 5)); }
__host__ __device__ __forceinline__ void stage_rc(int b, int& R, int& C) { const int st = b / 1024, sb = b % 1024, swz = sb ^ (((sb >> 9) & 1) << 5); R = (st >> 1) * 16 + swz / 64; C = (st & 1) * 32 + (swz % 64) / 2; }
__host__ __device__ __forceinline__ int perm32(int rho) { const int n = rho >> 4, i = rho & 15; return 8 * (i >> 2) + 4 * n + (i & 3); }

struct Unit { int pm, pn; };
struct Gemm { const bf16_t* A; const bf16_t* Bt; int M, N, K; };

struct StaticOrder {
    int nM, nN, nwg, G, c;
    __host__ __device__ void init(int M, int N, int G_, int c_) { nM = M / BM; nN = N / BM; nwg = nM * nN; G = G_; c = c_; }
    __host__ __device__ bool next(int i, Unit& u) const {
        const long L = (long)i * G + c; if (L >= nwg) return false;
        int wgid = (int)L; { const int q = nwg / NXCD, r = nwg % NXCD, xcd = wgid % NXCD, off = wgid / NXCD; wgid = (xcd < r ? xcd * (q + 1) : r * (q + 1) + (xcd - r) * q) + off; }
        const int nig = WGM * nN, gid = wgid / nig, fm = gid * WGM, gsz = (nM - fm) < WGM ? (nM - fm) : WGM;
        u.pm = fm + ((wgid % nig) % gsz); u.pn = (wgid % nig) / gsz; return true;
    }
    __device__ __forceinline__ void a_ready(const Unit&) const {}
    __device__ __forceinline__ void done(const Unit&) const {}
};


__device__ __forceinline__ unsigned cvt_pk_bf16(float lo, float hi) { unsigned r; asm volatile("v_cvt_pk_bf16_f32 %0, %1, %2" : "=v"(r) : "v"(lo), "v"(hi)); return r; }

typedef unsigned u32x2 __attribute__((ext_vector_type(2)));
__device__ __forceinline__ u32x2 pack4(const f32x4 v) { u32x2 w; w.x = cvt_pk_bf16(v[0], v[1]); w.y = cvt_pk_bf16(v[2], v[3]); return w; }

struct EpiStoreBf16 {
    static constexpr bool PERM = false, AFTER_DRAIN = false;
    bf16_t* O; int ldc;
    __device__ __forceinline__ void operator()(f32x4 (&acc)[2][2][4][2], const Unit& u, int wr, int wc, int fr, int fq) const {
#pragma unroll
        for (int ai = 0; ai < 2; ++ai)
#pragma unroll
            for (int m = 0; m < 4; ++m) { bf16_t* rowp = O + (size_t)(u.pm * BM + ai * HALF + wr * 64 + m * 16 + fr) * ldc + u.pn * BM + wc * 32 + 4 * fq;
#pragma unroll
                for (int bj = 0; bj < 2; ++bj)
#pragma unroll
                    for (int n = 0; n < 2; ++n) *(u32x2*)(rowp + bj * HALF + n * 16) = pack4(acc[ai][bj][m][n]); }
    }
};

struct EpiResid {
    static constexpr bool PERM = false, AFTER_DRAIN = false;
    const float* xin_p; const float* xin_s; float* out; const float* mod; int goff; int row_base;
    __device__ __forceinline__ void operator()(f32x4 (&acc)[2][2][4][2], const Unit& u, int wr, int wc, int fr, int fq) const {
        const int grow0 = row_base + u.pm * BM; const bool smp = grow0 >= 8192;
        const int col0 = u.pn * BM + wc * 32 + 4 * fq;
        const float* xin = (smp ? xin_s + (size_t)(grow0 - 8192) * 1024 : xin_p + (size_t)grow0 * 1024) + col0;
        const float* gate = mod + (smp ? 1 + ((grow0 - 8192) >> 11) : 0) * 6144 + goff + col0;
        float* o = out + (size_t)grow0 * 1024 + col0;
        f32x4 g[2][2];
#pragma unroll
        for (int bj = 0; bj < 2; ++bj)
#pragma unroll
            for (int n = 0; n < 2; ++n) g[bj][n] = *(const f32x4*)(gate + bj * HALF + n * 16);
#pragma unroll
        for (int ai = 0; ai < 2; ++ai)
#pragma unroll
            for (int m = 0; m < 4; ++m) { int rl = ai * HALF + wr * 64 + m * 16 + fr; asm volatile("" : "+v"(rl)); const size_t off = (size_t)rl * 1024;
#pragma unroll
                for (int bj = 0; bj < 2; ++bj)
#pragma unroll
                    for (int n = 0; n < 2; ++n) { const f32x4 x = *(const f32x4*)(xin + off + bj * HALF + n * 16); *(f32x4*)(o + off + bj * HALF + n * 16) = x + g[bj][n] * acc[ai][bj][m][n]; }
                if (m & 1) asm volatile("" ::: "memory"); }
    }
};

struct EpiProj {
    static constexpr bool PERM = false, AFTER_DRAIN = false;
    unsigned char* ws; float* out;
    __device__ __forceinline__ void operator()(f32x4 (&acc)[2][2][4][2], const Unit& u, int wr, int wc, int fr, int fq) const {
        const int pn = u.pn, grow0 = u.pm * BM; const bool smp = u.pm >= 32;
        const int sb = (grow0 - 8192) >> 11, st0 = (grow0 - 8192) & 2047;
        const size_t kvrow = smp ? (size_t)(sb * 2304 + 256 + st0) : (size_t)grow0;
        bf16_t* d16; int ld16; float* d32 = nullptr;
        if (pn < 2)       { d16 = (bf16_t*)(ws + WS_U) + (size_t)grow0 * 512 + pn * BM; ld16 = 512; }
        else if (pn < 6)  { d16 = (bf16_t*)(ws + WS_Q) + (size_t)grow0 * 1024 + (pn - 2) * BM; ld16 = 1024; }
        else if (pn < 10) { d16 = (bf16_t*)(ws + (smp ? WS_KS : WS_KP)) + kvrow * 1024 + (pn - 6) * BM; ld16 = 1024; if (!smp) d32 = out + OUT_K + (size_t)grow0 * 1024 + (pn - 6) * BM; }
        else if (pn < 14) { d16 = (bf16_t*)(ws + (smp ? WS_VS : WS_VP)) + kvrow * 1024 + (pn - 10) * BM; ld16 = 1024; if (!smp) d32 = out + OUT_V + (size_t)grow0 * 1024 + (pn - 10) * BM; }
        else              { d16 = (bf16_t*)out + (size_t)grow0 * 2048 + (pn - 14) * BM; ld16 = 2048; }
        const bool do_rope = smp && pn >= 2 && pn < 10, do_sig = pn >= 14;
        const float* ropeC = (const float*)(ws + WS_MISC + MISC_ROPEC) + 4 * fq; const float* ropeS = (const float*)(ws + WS_MISC + MISC_ROPES) + 4 * fq;
#pragma unroll
        for (int ai = 0; ai < 2; ++ai)
#pragma unroll
            for (int m = 0; m < 4; ++m) { int rl = ai * HALF + wr * 64 + m * 16 + fr; asm volatile("" : "+v"(rl));
                f32x4 v[2][2];
#pragma unroll
                for (int bj = 0; bj < 2; ++bj)
#pragma unroll
                    for (int n = 0; n < 2; ++n) v[bj][n] = acc[ai][bj][m][n];
                if (do_rope) { const int t = st0 + rl; const int pos = (wc & 1) ? (t & 63) : (t >> 6);
                    const f32x4 c4 = *(const f32x4*)(ropeC + pos * 16), s4 = *(const f32x4*)(ropeS + pos * 16);
#pragma unroll
                    for (int bj = 0; bj < 2; ++bj) { const f32x4 x1 = v[bj][0], x2 = v[bj][1]; v[bj][0] = x1 * c4 - x2 * s4; v[bj][1] = x2 * c4 + x1 * s4; } }
                if (pn >= 2 && pn < 6) {
#pragma unroll
                    for (int bj = 0; bj < 2; ++bj)
#pragma unroll
                        for (int n = 0; n < 2; ++n) v[bj][n] = v[bj][n] * QSCALE; }
                if (do_sig) {
#pragma unroll
                    for (int bj = 0; bj < 2; ++bj)
#pragma unroll
                        for (int n = 0; n < 2; ++n)
#pragma unroll
                            for (int i = 0; i < 4; ++i) v[bj][n][i] = __builtin_amdgcn_rcpf(1.0f + __expf(-v[bj][n][i])); }
                bf16_t* rowp = d16 + (size_t)rl * ld16 + wc * 32 + 4 * fq;
#pragma unroll
                for (int bj = 0; bj < 2; ++bj)
#pragma unroll
                    for (int n = 0; n < 2; ++n) *(u32x2*)(rowp + bj * HALF + n * 16) = pack4(v[bj][n]);
                if (d32) { float* rp = d32 + (size_t)rl * 1024 + wc * 32 + 4 * fq;
#pragma unroll
                    for (int bj = 0; bj < 2; ++bj)
#pragma unroll
                        for (int n = 0; n < 2; ++n) *(f32x4*)(rp + bj * HALF + n * 16) = v[bj][n]; }
                asm volatile("" ::: "memory"); }
    }
};

__device__ __forceinline__ f32x4 unpack4(const u32x2 w) { f32x4 v; v[0] = __builtin_bit_cast(float, w.x << 16); v[1] = __builtin_bit_cast(float, w.x & 0xffff0000u); v[2] = __builtin_bit_cast(float, w.y << 16); v[3] = __builtin_bit_cast(float, w.y & 0xffff0000u); return v; }

struct EpiPoolMix {
    static constexpr bool PERM = false, AFTER_DRAIN = false;
    bf16_t* O; const float* ps;
    __device__ __forceinline__ void operator()(f32x4 (&acc)[2][2][4][2], const Unit& u, int wr, int wc, int fr, int fq) const {
        const int col0 = u.pn * BM + wc * 32 + 4 * fq; f32x4 s[2][2];
#pragma unroll
        for (int bj = 0; bj < 2; ++bj)
#pragma unroll
            for (int n = 0; n < 2; ++n) s[bj][n] = *(const f32x4*)(ps + col0 + bj * HALF + n * 16);
#pragma unroll
        for (int ai = 0; ai < 2; ++ai)
#pragma unroll
            for (int m = 0; m < 4; ++m) { int rl = ai * HALF + wr * 64 + m * 16 + fr; asm volatile("" : "+v"(rl)); bf16_t* rowp = O + (size_t)(u.pm * BM + rl) * 512 + col0;
#pragma unroll
                for (int bj = 0; bj < 2; ++bj)
#pragma unroll
                    for (int n = 0; n < 2; ++n) *(u32x2*)(rowp + bj * HALF + n * 16) = pack4(acc[ai][bj][m][n] * s[bj][n]); }
    }
};
template <int SECOND> struct EpiGate {
    static constexpr bool PERM = false, AFTER_DRAIN = false;
    bf16_t* MG; const bf16_t* G;
    __device__ __forceinline__ void operator()(f32x4 (&acc)[2][2][4][2], const Unit& u, int wr, int wc, int fr, int fq) const {
        const int col0 = u.pn * BM + wc * 32 + 4 * fq;
#pragma unroll
        for (int ai = 0; ai < 2; ++ai)
#pragma unroll
            for (int m = 0; m < 4; ++m) { int rl = ai * HALF + wr * 64 + m * 16 + fr; asm volatile("" : "+v"(rl)); const size_t row = (size_t)(u.pm * BM + rl);
                const bf16_t* gp = G + row * 2048 + SECOND * 1024 + col0; bf16_t* mp = MG + row * 1024 + col0;
#pragma unroll
                for (int bj = 0; bj < 2; ++bj)
#pragma unroll
                    for (int n = 0; n < 2; ++n) { const f32x4 g = unpack4(*(const u32x2*)(gp + bj * HALF + n * 16)); f32x4 r = g * acc[ai][bj][m][n];
                        if (SECOND) r = r + unpack4(*(const u32x2*)(mp + bj * HALF + n * 16));
                        *(u32x2*)(mp + bj * HALF + n * 16) = pack4(r); }
                asm volatile("" ::: "memory"); }
    }
};
__device__ __forceinline__ float dpp_ror1_s(float x) { return __builtin_bit_cast(float, __builtin_amdgcn_update_dpp(0, __builtin_bit_cast(int, x), 0x121, 0xf, 0xf, false)); }
__device__ __forceinline__ float dpp_ror15_s(float x) { return __builtin_bit_cast(float, __builtin_amdgcn_update_dpp(0, __builtin_bit_cast(int, x), 0x12f, 0xf, 0xf, false)); }
__device__ __forceinline__ f32x4 dpp_ror1(const f32x4 v) { const float a = dpp_ror1_s(v[0]), b = dpp_ror1_s(v[1]), c = dpp_ror1_s(v[2]), d = dpp_ror1_s(v[3]); return (f32x4){a, b, c, d}; }
__device__ __forceinline__ f32x4 dpp_ror15(const f32x4 v) { const float a = dpp_ror15_s(v[0]), b = dpp_ror15_s(v[1]), c = dpp_ror15_s(v[2]), d = dpp_ror15_s(v[3]); return (f32x4){a, b, c, d}; }
struct EpiFfn {
    static constexpr bool PERM = false, AFTER_DRAIN = false;
    bf16_t* ACT; const float* cw; const float* cb; float* side; PG8_LAS float* edge;
    __device__ __forceinline__ void operator()(f32x4 (&acc)[2][2][4][2], const Unit& u, int wr, int wc, int fr, int fq) const {
        const int c128 = wc * 32 + 4 * fq;
#pragma unroll
        for (int ai = 0; ai < 2; ++ai) { const int rb = 2 * ai + wr;
            if (fr == 0) {
#pragma unroll
                for (int n = 0; n < 2; ++n) *(PG8_LAS f32x4*)(edge + (rb * 2 + 0) * 128 + c128 + 16 * n) = acc[ai][0][0][n]; }
            if (fr == 15) {
#pragma unroll
                for (int n = 0; n < 2; ++n) *(PG8_LAS f32x4*)(edge + (rb * 2 + 1) * 128 + c128 + 16 * n) = acc[ai][0][3][n]; } }
        if (u.pm >= 32) { float* sb = side + (size_t)((u.pm * 22 + u.pn) * 6) * 128 + c128;
            if (wr == 0) {
                if (fr == 0) {
#pragma unroll
                    for (int n = 0; n < 2; ++n) { *(f32x4*)(sb + 0 * 128 + 16 * n) = acc[0][0][0][n]; *(f32x4*)(sb + 4 * 128 + 16 * n) = acc[0][1][0][n]; } }
                if (fr == 1) {
#pragma unroll
                    for (int n = 0; n < 2; ++n) *(f32x4*)(sb + 1 * 128 + 16 * n) = acc[0][0][0][n]; }
            } else {
                if (fr == 14) {
#pragma unroll
                    for (int n = 0; n < 2; ++n) *(f32x4*)(sb + 2 * 128 + 16 * n) = acc[1][0][3][n]; }
                if (fr == 15) {
#pragma unroll
                    for (int n = 0; n < 2; ++n) { *(f32x4*)(sb + 3 * 128 + 16 * n) = acc[1][0][3][n]; *(f32x4*)(sb + 5 * 128 + 16 * n) = acc[1][1][3][n]; } }
            } }
        asm volatile("s_waitcnt lgkmcnt(0)" ::: "memory"); __builtin_amdgcn_s_barrier(); asm volatile("" ::: "memory");
        const f32x4 zero4 = (f32x4){0.f, 0.f, 0.f, 0.f};
#pragma unroll
        for (int n = 0; n < 2; ++n) { const int gcol = u.pn * 128 + c128 + 16 * n;
            const f32x4 w0 = *(const f32x4*)(cw + gcol), w1 = *(const f32x4*)(cw + 2816 + gcol), w2 = *(const f32x4*)(cw + 5632 + gcol), bb = *(const f32x4*)(cb + gcol);
#pragma unroll
            for (int ai = 0; ai < 2; ++ai) { const int rb = 2 * ai + wr;
                const f32x4 ep = rb > 0 ? *(const PG8_LAS f32x4*)(edge + ((rb - 1) * 2 + 1) * 128 + c128 + 16 * n) : zero4;
                const f32x4 en = rb < 3 ? *(const PG8_LAS f32x4*)(edge + ((rb + 1) * 2 + 0) * 128 + c128 + 16 * n) : zero4;
                f32x4 pc = ep;
#pragma unroll
                for (int m = 0; m < 4; ++m) { int rl = ai * HALF + wr * 64 + m * 16 + fr; asm volatile("" : "+v"(rl));
                    const f32x4 a = acc[ai][0][m][n]; const f32x4 Pm = dpp_ror1(a), Nm = dpp_ror15(a);
                    const f32x4 nx = m < 3 ? dpp_ror15(acc[ai][0][m < 3 ? m + 1 : 3][n]) : en;
                    const f32x4 prev = fr == 0 ? pc : Pm, next = fr == 15 ? nx : Nm; pc = Pm;
                    f32x4 cv = w0 * prev + w1 * a + w2 * next + bb;
#pragma unroll
                    for (int i = 0; i < 4; ++i) cv[i] = cv[i] * __builtin_amdgcn_rcpf(1.0f + __expf(-cv[i]));
                    *(u32x2*)(ACT + (size_t)(u.pm * BM + rl) * 2816 + gcol) = pack4(cv * acc[ai][1][m][n]); } } }
    }
};

template <class Epi, class Sched, bool ALIGN_EPI = false, bool SP2 = false>
__device__ __forceinline__ void gemm_phase(PG8_LAS unsigned char* lds, const Gemm g, const Sched& S, const Epi& E) {
    int tid_ = threadIdx.x; asm volatile("" : "+v"(tid_));
    const int tid = tid_, wid = __builtin_amdgcn_readfirstlane(tid >> 6), lane = tid & 63, wr = wid >> 2, wc = wid & 3, fr = lane & 15, fq = lane >> 4;
    const int K = g.K, nt = K / BK;
    unsigned voffA[2], voffB[2];
#pragma unroll
    for (int i = 0; i < 2; ++i) { int R, C; stage_rc(tid * 16 + i * 8192, R, C); const int Rb = Epi::PERM ? ((R & ~31) + perm32(R & 31)) : R;
        voffA[i] = (unsigned)(R * K + C) * 2u; voffB[i] = (unsigned)(Rb * K + C) * 2u; }
    const size_t kstep = (size_t)(BK * 2);
    const size_t hstep = (size_t)HALF * K * 2;
    const size_t tstep = 2 * hstep;
    const unsigned ldsw = (unsigned)wid * 1024u;
    const int aoff = lds_byte(wr * 64 + fr, fq * 8), boff = lds_byte(wc * 32 + fr, fq * 8);
#define PG8_SA(b, h) (((b) * 2 + (h)) * HTB)
#define PG8_SB(b, h) ((4 + (b) * 2 + (h)) * HTB)
#define PG8_STAGE(bufoff, gbase, voff) do { _Pragma("unroll") for (int _i = 0; _i < 2; ++_i) \
        __builtin_amdgcn_global_load_lds((const unsigned*)((const char*)(gbase) + (voff)[_i]), (PG8_LAS unsigned*)(lds + (bufoff) + ldsw + _i * 8192), 16, 0, 0); } while (0)
#define PG8_LDA(dst, b, h) do { _Pragma("unroll") for (int m = 0; m < 4; ++m) _Pragma("unroll") for (int k = 0; k < 2; ++k) dst[m][k] = *(const PG8_LAS bf16x8*)(lds + PG8_SA(b, h) + aoff + m * 2048 + k * 1024); } while (0)
#define PG8_LDB(dst, b, h) do { _Pragma("unroll") for (int n = 0; n < 2; ++n) _Pragma("unroll") for (int k = 0; k < 2; ++k) dst[n][k] = *(const PG8_LAS bf16x8*)(lds + PG8_SB(b, h) + boff + n * 2048 + k * 1024); } while (0)
#define PG8_MMA(ai, bj, At, Bt) do { __builtin_amdgcn_s_setprio(1); _Pragma("unroll") for (int m = 0; m < 4; ++m) _Pragma("unroll") for (int n = 0; n < 2; ++n) _Pragma("unroll") for (int k = 0; k < 2; ++k) \
        acc[ai][bj][m][n] = __builtin_amdgcn_mfma_f32_16x16x32_bf16(Bt[n][k], At[m][k], acc[ai][bj][m][n], 0, 0, 0); __builtin_amdgcn_s_setprio(0); } while (0)
#define PG8_WAIT_V(n) asm volatile("s_waitcnt vmcnt(" #n ")" ::: "memory")
#define PG8_WAIT_L(n) asm volatile("s_waitcnt lgkmcnt(" #n ")" ::: "memory")
#define PG8_BAR __builtin_amdgcn_s_barrier()
#define PG8_SCHED __builtin_amdgcn_sched_barrier(0)
    Unit cur, nxt; int ui = 0;
    if (!S.next(0, cur)) return;
    f32x4 acc[2][2][4][2];
#pragma unroll
    for (int a = 0; a < 2; ++a)
#pragma unroll
        for (int b = 0; b < 2; ++b)
#pragma unroll
            for (int m = 0; m < 4; ++m)
#pragma unroll
                for (int n = 0; n < 2; ++n) acc[a][b][m][n] = (f32x4){0.f, 0.f, 0.f, 0.f};
    bf16x8 At[4][2], B0[2][2], B1[2][2];
    const char* cA = (const char*)g.A + (size_t)cur.pm * tstep; const char* cB = (const char*)g.Bt + (size_t)cur.pn * tstep;
    S.a_ready(cur);
    if constexpr (SP2) {
        PG8_STAGE(PG8_SB(0, 0), cB, voffB); PG8_STAGE(PG8_SB(0, 1), cB + hstep, voffB); PG8_STAGE(PG8_SA(0, 0), cA, voffA); PG8_STAGE(PG8_SA(0, 1), cA + hstep, voffA);
        if (wr == 1) PG8_BAR;
        PG8_WAIT_V(2); PG8_BAR;
        PG8_STAGE(PG8_SB(1, 0), cB + kstep, voffB); PG8_STAGE(PG8_SA(1, 0), cA + kstep, voffA); PG8_STAGE(PG8_SB(1, 1), cB + hstep + kstep, voffB);
        PG8_WAIT_V(6); PG8_BAR;
    } else {
        PG8_STAGE(PG8_SB(0, 0), cB, voffB); PG8_STAGE(PG8_SA(0, 0), cA, voffA); PG8_STAGE(PG8_SB(0, 1), cB + hstep, voffB); PG8_STAGE(PG8_SA(0, 1), cA + hstep, voffA);
        if (wr == 1) PG8_BAR;
        PG8_WAIT_V(4); PG8_BAR;
        PG8_STAGE(PG8_SB(1, 0), cB + kstep, voffB); PG8_STAGE(PG8_SA(1, 0), cA + kstep, voffA); PG8_STAGE(PG8_SB(1, 1), cB + hstep + kstep, voffB);
        PG8_WAIT_V(6); PG8_BAR;
    }
    for (;;) {
        const bool has_next = S.next(ui + 1, nxt);
        const char* nA = has_next ? (const char*)g.A + (size_t)nxt.pm * tstep : cA; const char* nB = has_next ? (const char*)g.Bt + (size_t)nxt.pn * tstep : cB;
        for (int t = 0; t < nt; t += 2) {
            const bool last = (t == nt - 2);
            const char* a1 = cA + (size_t)(t + 1) * kstep;
            const char* a2 = last ? nA : cA + (size_t)(t + 2) * kstep; const char* b2 = last ? nB : cB + (size_t)(t + 2) * kstep;
            const char* a3 = a2 + kstep; const char* b3 = b2 + kstep;
            if (last && has_next) S.a_ready(nxt);
            if constexpr (SP2) {
            PG8_LDB(B0, 0, 0); PG8_LDB(B1, 0, 1); PG8_SCHED; PG8_LDA(At, 0, 0); PG8_STAGE(PG8_SA(1, 1), a1 + hstep, voffA);
            PG8_WAIT_V(8); PG8_WAIT_L(0); PG8_BAR; PG8_MMA(0, 0, At, B0); PG8_MMA(0, 1, At, B1); PG8_BAR; PG8_SCHED;
            PG8_LDA(At, 0, 1); PG8_STAGE(PG8_SB(0, 0), b2, voffB); PG8_STAGE(PG8_SB(0, 1), b2 + hstep, voffB); PG8_STAGE(PG8_SA(0, 0), a2, voffA);
            PG8_WAIT_V(8); PG8_WAIT_L(0); PG8_BAR; PG8_MMA(1, 0, At, B0); PG8_MMA(1, 1, At, B1); PG8_BAR; PG8_SCHED;
            PG8_LDB(B0, 1, 0); PG8_LDB(B1, 1, 1); PG8_SCHED; PG8_LDA(At, 1, 0); PG8_STAGE(PG8_SA(0, 1), a2 + hstep, voffA);
            PG8_WAIT_V(8); PG8_WAIT_L(0); PG8_BAR; PG8_MMA(0, 0, At, B0); PG8_MMA(0, 1, At, B1); PG8_BAR; PG8_SCHED;
            PG8_LDA(At, 1, 1); PG8_STAGE(PG8_SB(1, 0), b3, voffB); PG8_STAGE(PG8_SB(1, 1), b3 + hstep, voffB); PG8_STAGE(PG8_SA(1, 0), a3, voffA);
            PG8_WAIT_V(8); PG8_WAIT_L(0); PG8_BAR; PG8_MMA(1, 0, At, B0); PG8_MMA(1, 1, At, B1); PG8_BAR; PG8_SCHED;
            } else {
            PG8_LDB(B0, 0, 0); PG8_SCHED; PG8_LDA(At, 0, 0); PG8_STAGE(PG8_SA(1, 1), a1 + hstep, voffA);
            PG8_WAIT_L(8); PG8_BAR; PG8_WAIT_L(0); PG8_MMA(0, 0, At, B0); PG8_BAR; PG8_SCHED;
            PG8_LDB(B1, 0, 1); PG8_STAGE(PG8_SB(0, 0), b2, voffB);
            PG8_BAR; PG8_WAIT_L(0); PG8_MMA(0, 1, At, B1); PG8_BAR;
            PG8_LDA(At, 0, 1); PG8_STAGE(PG8_SA(0, 0), a2, voffA);
            PG8_BAR; PG8_WAIT_L(0); PG8_MMA(1, 0, At, B0); PG8_BAR; PG8_SCHED;
            PG8_STAGE(PG8_SB(0, 1), b2 + hstep, voffB);
            PG8_WAIT_V(6); PG8_BAR; PG8_MMA(1, 1, At, B1); PG8_BAR;
            PG8_LDB(B0, 1, 0); PG8_SCHED; PG8_LDA(At, 1, 0); PG8_STAGE(PG8_SA(0, 1), a2 + hstep, voffA);
            PG8_WAIT_L(8); PG8_BAR; PG8_WAIT_L(0); PG8_MMA(0, 0, At, B0); PG8_BAR; PG8_SCHED;
            PG8_LDB(B1, 1, 1); PG8_STAGE(PG8_SB(1, 0), b3, voffB);
            PG8_BAR; PG8_WAIT_L(0); PG8_MMA(0, 1, At, B1); PG8_BAR;
            PG8_LDA(At, 1, 1); PG8_STAGE(PG8_SA(1, 0), a3, voffA);
            PG8_BAR; PG8_WAIT_L(0); PG8_MMA(1, 0, At, B0); PG8_BAR; PG8_SCHED;
            PG8_STAGE(PG8_SB(1, 1), b3 + hstep, voffB);
            PG8_WAIT_V(6); PG8_BAR; PG8_MMA(1, 1, At, B1); PG8_BAR;
            }
        }
        if constexpr (ALIGN_EPI) { if (wr == 0) PG8_BAR; }
        if constexpr (!Epi::AFTER_DRAIN) { E(acc, cur, wr, wc, fr, fq); S.done(cur); }
        if (!has_next) break;
#pragma unroll
        for (int a = 0; a < 2; ++a)
#pragma unroll
            for (int b = 0; b < 2; ++b)
#pragma unroll
                for (int m = 0; m < 4; ++m)
#pragma unroll
                    for (int n = 0; n < 2; ++n) acc[a][b][m][n] = (f32x4){0.f, 0.f, 0.f, 0.f};
        cur = nxt; cA = nA; cB = nB; ++ui;
        if constexpr (ALIGN_EPI) { if (wr == 1) PG8_BAR; }
    }
    PG8_WAIT_V(0);
    if constexpr (!ALIGN_EPI) { if (wr == 0) PG8_BAR; }
    PG8_BAR;
    if constexpr (Epi::AFTER_DRAIN) { E.fused(acc, cur, wr, wc, fr, fq, lds, wid, lane); S.done(cur); }
#undef PG8_SA
#undef PG8_SB
#undef PG8_STAGE
#undef PG8_LDA
#undef PG8_LDB
#undef PG8_MMA
#undef PG8_WAIT_V
#undef PG8_WAIT_L
#undef PG8_BAR
#undef PG8_SCHED
}
}

#define GAS __attribute__((address_space(1)))
#define LAS __attribute__((address_space(3)))
typedef unsigned short bf16;
typedef unsigned v4u __attribute__((ext_vector_type(4)));
typedef float f32x4 __attribute__((ext_vector_type(4)));
typedef short bf16x8 __attribute__((ext_vector_type(8)));
typedef GAS unsigned gu32;
typedef GAS unsigned long long gu64;
#define RLX_AGENT __ATOMIC_RELAXED, __HIP_MEMORY_SCOPE_AGENT
#define LDS_WAIT() asm volatile("s_waitcnt lgkmcnt(0)" ::: "memory")
#define VM_WAIT() asm volatile("s_waitcnt vmcnt(0)" ::: "memory")
__device__ __forceinline__ unsigned long long rt() { return __builtin_amdgcn_s_memrealtime(); }
__device__ __forceinline__ unsigned f2bf(float f) { unsigned u = __builtin_bit_cast(unsigned, f); return (u + 0x7fffu + ((u >> 16) & 1u)) >> 16; }
__device__ __forceinline__ unsigned pk2(float lo, float hi) { return f2bf(lo) | (f2bf(hi) << 16); }

#define XB_TMO      128
#define XB_XCNT(j)  (256  + 64 * (j))
#define XB_XSUB(j)  (1280 + 64 * (j))
#define XB_XGEN(j)  (2304 + 64 * (j))
#define XB_TOP      3328
#define XB_TOPGEN   3392
#define XCD_BAR_WORDS 3456
#define XB_SPIN_CAP (1u << 18)

__device__ __forceinline__ unsigned xb_ld(unsigned* p)              { return __hip_atomic_load(p, __ATOMIC_RELAXED, __HIP_MEMORY_SCOPE_AGENT); }
__device__ __forceinline__ unsigned xb_add(unsigned* p, unsigned v) { return __hip_atomic_fetch_add(p, v, __ATOMIC_RELAXED, __HIP_MEMORY_SCOPE_AGENT); }
__device__ __forceinline__ unsigned xb_xcc_id() { return (unsigned)__builtin_amdgcn_s_getreg((3 << 11) | 20) & 0xFu; }
#define XB_SPIN(cond, bar) do { unsigned _sp = 0; while (cond) { __builtin_amdgcn_s_sleep(1); \
    if ((++_sp & 255u) == 0u) { if (xb_ld(&(bar)[XB_TMO])) break; if (_sp > XB_SPIN_CAP) { atomicAdd(&(bar)[XB_TMO], 1u); break; } } } } while (0)

struct XcdBarrier {
    unsigned* bar; unsigned x;
    volatile LAS unsigned* st;
};

__device__ __forceinline__ XcdBarrier xcd_barrier_post(unsigned* bar, volatile LAS unsigned* st) {
    XcdBarrier b; b.bar = bar; b.x = xb_xcc_id(); b.st = st;
    if (threadIdx.x == 0) (void)xb_add(&bar[XB_XCNT(b.x)], 1u);
    return b;
}
__device__ __forceinline__ void xcd_barrier_complete(unsigned* bar, unsigned x, unsigned& nloc, unsigned& nx) {
    const unsigned G = gridDim.x * gridDim.y * gridDim.z;
    unsigned sum, cnt, mine, sp = 0u;
    for (;;) {
        sum = 0u; cnt = 0u; mine = 0u;
#pragma unroll
        for (unsigned j = 0; j < 16; ++j) { const unsigned c = xb_ld(&bar[XB_XCNT(j)]); sum += c; cnt += (c > 0u) ? 1u : 0u; mine = (j == x) ? c : mine; }
        if (sum == G) break;
        __builtin_amdgcn_s_sleep(1);
        if ((++sp & 255u) == 0u) { if (xb_ld(&bar[XB_TMO])) break; if (sp > XB_SPIN_CAP) { atomicAdd(&bar[XB_TMO], 1u); break; } }
    }
    nloc = mine > 0u ? mine : 1u; nx = cnt > 0u ? cnt : 1u;
}

__device__ __forceinline__ void xcd_barrier(const XcdBarrier& b) {
    asm volatile("s_waitcnt vmcnt(0)" ::: "memory");
    __syncthreads();
    if (threadIdx.x == 0) {
        unsigned* bar = b.bar;
        __builtin_amdgcn_s_waitcnt(0);
        unsigned nloc = b.st[0], nx = b.st[1];
        if (nloc == 0u) { xcd_barrier_complete(bar, b.x, nloc, nx); b.st[0] = nloc; b.st[1] = nx; }
        const unsigned old = xb_add(&bar[XB_XSUB(b.x)], 1u);
        const unsigned gen = old / nloc;
        if (old + 1u == (gen + 1u) * nloc) {
            __builtin_amdgcn_fence(__ATOMIC_RELEASE, "agent");
            asm volatile("s_waitcnt vmcnt(0)" ::: "memory");
            const unsigned og = xb_add(&bar[XB_TOP], 1u);
            const unsigned tg = og / nx;
            if (og + 1u == (tg + 1u) * nx) xb_add(&bar[XB_TOPGEN], 1u);
            else XB_SPIN(xb_ld(&bar[XB_TOPGEN]) == tg, bar);
            __builtin_amdgcn_fence(__ATOMIC_ACQUIRE, "agent");
            xb_add(&bar[XB_XGEN(b.x)], 1u);
            asm volatile("s_waitcnt vmcnt(0)" ::: "memory");
        } else {
            XB_SPIN(xb_ld(&bar[XB_XGEN(b.x)]) == gen, bar);
            __builtin_amdgcn_fence(__ATOMIC_ACQUIRE, "agent");
            asm volatile("s_waitcnt vmcnt(0)" ::: "memory");
        }
    }
    __syncthreads();
}

namespace att {
using bf16x8 = __attribute__((ext_vector_type(8))) short;
using s16x4 = __attribute__((ext_vector_type(4))) short;
using f32x16 = __attribute__((ext_vector_type(16))) float;
using u32x4 = __attribute__((ext_vector_type(4))) unsigned;
typedef __attribute__((address_space(3))) const char* lds_cptr;
typedef short v4i16_t __attribute__((ext_vector_type(4)));
typedef float f32x2_t __attribute__((ext_vector_type(2))); typedef __bf16 bf16x2_t __attribute__((ext_vector_type(2)));
constexpr int SLOTB = 32768, NSLOT = 3, LDS_WSF = NSLOT * SLOTB, STG = 132;
constexpr float C2 = 0.125f * 1.4426950408889634f;
__device__ __forceinline__ int crow(int r, int hi) { return (r & 3) + 8 * (r >> 2) + 4 * hi; }
__device__ __forceinline__ void glds16(const void* gsrc, unsigned lds_dst) { unsigned keep;
    asm volatile("s_mov_b32 %0, m0\n\ts_mov_b32 m0, %2\n\ts_nop 0\n\tglobal_load_lds_dwordx4 %1, off\n\ts_mov_b32 m0, %0" : "=&s"(keep) : "v"(gsrc), "s"(lds_dst) : "memory"); }
__device__ __forceinline__ unsigned cvtpk_s(float lo, float hi) { f32x2_t v = {lo, hi}; bf16x2_t b = __builtin_convertvector(v, bf16x2_t); return __builtin_bit_cast(unsigned, b); }
__device__ __forceinline__ s16x4 vtr(lds_cptr p) { return __builtin_bit_cast(s16x4, __builtin_amdgcn_ds_read_tr16_b64_v4i16((__attribute__((address_space(3))) v4i16_t*)p)); }
#define ATT_WAIT_BAR(N) asm volatile("s_waitcnt vmcnt(" #N ") lgkmcnt(0)\n\ts_barrier" ::: "memory")
#define ATT_MFMA(a, b, c) __builtin_amdgcn_mfma_f32_32x32x16_bf16((a), (b), (c), 0, 0, 0)

template <int THRL> __device__ __forceinline__ void attn_unit(unsigned short* Qrows, const unsigned short* Kb, const unsigned short* Vb, int NT, int h, float lam, const float* subln, __attribute__((address_space(3))) char* shm) {
    int tid_ = threadIdx.x; asm volatile("" : "+v"(tid_));
    const int tid = tid_, lane = tid & 63, r32 = lane & 31, hi = lane >> 5; const int wid = __builtin_amdgcn_readfirstlane(tid >> 6); const int qb = wid & 3, mp = wid >> 2;
    const unsigned lds0 = (unsigned)(uintptr_t)shm;
    __attribute__((address_space(3))) float* wsf = (__attribute__((address_space(3))) float*)(shm + LDS_WSF) + wid * 64;
    const unsigned short* ksrc = Kb + (size_t)lane * 1024 + h * 128 + wid * 8;
    const unsigned short* vsrc = Vb + (size_t)(16 * (wid & 3) + (lane >> 2)) * 1024 + h * 128 + (wid >> 2) * 32 + (lane & 3) * 8;
    const unsigned kdst = lds0 + wid * 1024, vdst = lds0 + 16384 + wid * 1024;
#define ATT_DMA(t, slot) do { const size_t to_ = (size_t)(t) * 65536; const unsigned so_ = (unsigned)(slot); \
        glds16(ksrc + to_, (unsigned)__builtin_amdgcn_readfirstlane(kdst + so_)); glds16(ksrc + to_ + 64, (unsigned)__builtin_amdgcn_readfirstlane(kdst + 8192 + so_)); \
        glds16(vsrc + to_, (unsigned)__builtin_amdgcn_readfirstlane(vdst + so_)); glds16(vsrc + to_ + 64, (unsigned)__builtin_amdgcn_readfirstlane(vdst + 8192 + so_)); } while (0)
    bf16x8 qr[4];
    { const unsigned short* Qw = Qrows + (size_t)(qb * 32 + r32) * 1024 + h * 128 + mp * 64 + hi * 8;
#pragma unroll
      for (int d0 = 0; d0 < 4; ++d0) qr[d0] = *(const bf16x8*)(Qw + d0 * 16); }
    ATT_DMA(0, 0);
    if (NT > 1) ATT_DMA(1, SLOTB);
    const lds_cptr kp0 = (lds_cptr)shm + mp * 8192 + hi * 1024 + r32 * 16;
    const lds_cptr vp0 = (lds_cptr)shm + 16384 + ((lane >> 4) & 1) * 32 + (lane & 3) * 8 + (4 * hi + ((lane & 15) >> 2)) * 64;
    float mhat = 0.f, l_reg = 0.f; f32x16 o[4]; f32x16 negm;
#pragma unroll
    for (int d = 0; d < 4; ++d) o[d] = f32x16{};
    negm = f32x16{};
    int sl_cur = 0, sl_nn = 2 * SLOTB;
    for (int t = 0; t < NT; ++t) {
        if (t + 1 < NT) ATT_WAIT_BAR(4); else ATT_WAIT_BAR(0);
        if (t + 2 < NT) ATT_DMA(t + 2, sl_nn);
        f32x16 p0, p1;
        { const lds_cptr kp = kp0 + sl_cur;
#pragma unroll
          for (int d0 = 0; d0 < 4; ++d0) { const bf16x8 k0 = *(const __attribute__((address_space(3))) bf16x8*)(kp + d0 * 2048), k1 = *(const __attribute__((address_space(3))) bf16x8*)(kp + d0 * 2048 + 512);
              p0 = ATT_MFMA(k0, qr[d0], d0 == 0 ? negm : p0); p1 = ATT_MFMA(k1, qr[d0], d0 == 0 ? negm : p1); } }
        float rm;
        { float a = fmaxf(fmaxf(p0[0], p0[1]), p1[0]), b = fmaxf(fmaxf(p0[2], p0[3]), p1[1]); a = fmaxf(fmaxf(a, p1[2]), p1[3]);
#pragma unroll
          for (int r = 4; r < 16; r += 4) { a = fmaxf(fmaxf(a, p0[r]), p0[r + 1]); b = fmaxf(fmaxf(b, p0[r + 2]), p0[r + 3]); a = fmaxf(fmaxf(a, p1[r]), p1[r + 1]); b = fmaxf(fmaxf(b, p1[r + 2]), p1[r + 3]); }
          rm = fmaxf(a, b); auto rr = __builtin_amdgcn_permlane32_swap(__float_as_uint(rm), __float_as_uint(rm), false, false); rm = fmaxf(__uint_as_float(rr[0]), __uint_as_float(rr[1])); }
        if (t == 0 || __any(rm > (float)THRL)) {
            const float dl = (t == 0) ? rm : fmaxf(rm, 0.f); mhat += dl;
#pragma unroll
            for (int r = 0; r < 16; ++r) { p0[r] -= dl; p1[r] -= dl; }
#pragma unroll
            for (int r = 0; r < 16; ++r) negm[r] = -mhat;
            if (t > 0) { const float f = __builtin_amdgcn_exp2f(-dl); l_reg *= f; if (hi == 0) wsf[r32] = f;
                float fr_[16];
#pragma unroll
                for (int r = 0; r < 16; ++r) fr_[r] = wsf[crow(r, hi)];
#pragma unroll
                for (int d = 0; d < 4; ++d)
#pragma unroll
                    for (int r = 0; r < 16; ++r) o[d][r] *= fr_[r]; }
        }
        float sacc = 0.f;
#pragma unroll
        for (int r = 0; r < 16; ++r) { p0[r] = __builtin_amdgcn_exp2f(p0[r]); p1[r] = __builtin_amdgcn_exp2f(p1[r]); sacc += p0[r] + p1[r]; }
        l_reg += sacc;
        u32x4 pw[4];
#pragma unroll
        for (int s = 0; s < 2; ++s) { pw[s] = (u32x4){cvtpk_s(p0[8 * s], p0[8 * s + 1]), cvtpk_s(p0[8 * s + 2], p0[8 * s + 3]), cvtpk_s(p0[8 * s + 4], p0[8 * s + 5]), cvtpk_s(p0[8 * s + 6], p0[8 * s + 7])};
            pw[2 + s] = (u32x4){cvtpk_s(p1[8 * s], p1[8 * s + 1]), cvtpk_s(p1[8 * s + 2], p1[8 * s + 3]), cvtpk_s(p1[8 * s + 4], p1[8 * s + 5]), cvtpk_s(p1[8 * s + 6], p1[8 * s + 7])}; }
        { const lds_cptr vp = vp0 + sl_cur;
#pragma unroll
          for (int db = 0; db < 4; ++db) {
#pragma unroll
              for (int ks = 0; ks < 4; ++ks) { const s16x4 lo = vtr(vp + db * 4096 + ks * 1024), hh = vtr(vp + db * 4096 + ks * 1024 + 512);
                  const bf16x8 vf = (bf16x8){lo[0], lo[1], lo[2], lo[3], hh[0], hh[1], hh[2], hh[3]};
                  o[db] = ATT_MFMA(__builtin_bit_cast(bf16x8, pw[ks]), vf, o[db]); } } }
        sl_cur = (sl_cur == 2 * SLOTB) ? 0 : sl_cur + SLOTB; sl_nn = (sl_nn == 2 * SLOTB) ? 0 : sl_nn + SLOTB;
    }
    { auto rr = __builtin_amdgcn_permlane32_swap(__float_as_uint(l_reg), __float_as_uint(l_reg), false, false); l_reg = __uint_as_float(rr[0]) + __uint_as_float(rr[1]); }
    if (hi == 0) wsf[32 + r32] = l_reg;
    { float rli[16];
#pragma unroll
      for (int r = 0; r < 16; ++r) rli[r] = 1.0f / wsf[32 + crow(r, hi)];
#pragma unroll
      for (int d = 0; d < 4; ++d)
#pragma unroll
          for (int r = 0; r < 16; ++r) o[d][r] *= rli[r]; }
    ATT_WAIT_BAR(0);
    __attribute__((address_space(3))) float* stg = (__attribute__((address_space(3))) float*)shm + qb * (32 * STG);
    if (mp == 1) {
#pragma unroll
        for (int d = 0; d < 4; ++d)
#pragma unroll
            for (int r = 0; r < 16; ++r) stg[crow(r, hi) * STG + d * 32 + r32] = o[d][r];
    }
    ATT_WAIT_BAR(0);
    if (mp == 0) {
#pragma unroll
        for (int d = 0; d < 4; ++d)
#pragma unroll
            for (int r = 0; r < 16; ++r) { const int a_ = crow(r, hi) * STG + d * 32 + r32; const float res = o[d][r] - lam * stg[a_]; stg[a_] = res; }
        asm volatile("s_waitcnt lgkmcnt(0)" ::: "memory");
        const __attribute__((address_space(3))) float* rowp = stg + r32 * STG + hi * 64;
        f32x4 v[16]; float ssq = 0.f;
#pragma unroll
        for (int i = 0; i < 16; ++i) { v[i] = *(const __attribute__((address_space(3))) f32x4*)(rowp + 4 * i); ssq += (v[i][0] * v[i][0] + v[i][1] * v[i][1]) + (v[i][2] * v[i][2] + v[i][3] * v[i][3]); }
        { auto rr = __builtin_amdgcn_permlane32_swap(__float_as_uint(ssq), __float_as_uint(ssq), false, false); ssq = __uint_as_float(rr[0]) + __uint_as_float(rr[1]); }
        const float rs = 0.8f / sqrtf(ssq * (1.0f / 128.0f) + 1e-6f);
        unsigned short* op = Qrows + (size_t)(qb * 32 + r32) * 1024 + h * 128 + hi * 64; const float* sw = subln + hi * 64;
#pragma unroll
        for (int i = 0; i < 16; i += 2) { const f32x4 g0 = *(const f32x4*)(sw + 4 * i), g1 = *(const f32x4*)(sw + 4 * i + 4); const f32x4 a = v[i] * g0 * rs, b = v[i + 1] * g1 * rs;
            u32x4 w; w.x = cvtpk_s(a[0], a[1]); w.y = cvtpk_s(a[2], a[3]); w.z = cvtpk_s(b[0], b[1]); w.w = cvtpk_s(b[2], b[3]); *(u32x4*)(op + 4 * i) = w; }
    }
    asm volatile("s_waitcnt vmcnt(0)" ::: "memory");
    ATT_WAIT_BAR(0);
#undef ATT_DMA
}
}

struct Args { const float* in[26]; float* out; unsigned char* ws; };
enum { I_XP = 0, I_XS, I_CK, I_CV, I_C, I_CCTX, I_WADA, I_BADA, I_WIN, I_WPOOL, I_PSCALE, I_WPA, I_WPB, I_WOUT, I_LQ1, I_LK1, I_LQ2, I_LK2, I_SUBLN, I_N1, I_N2, I_WFI, I_CONVW, I_CONVB, I_WFO, I_FN };

struct Ctx { LAS unsigned char* lds; int tid, lane, wave, G, bid; };
template <int I> __device__ __forceinline__ unsigned long long karg_raw() {
    unsigned long long v; auto kp = __builtin_amdgcn_kernarg_segment_ptr();
    asm volatile("s_load_dwordx2 %0, %1, %2\n\ts_waitcnt lgkmcnt(0)" : "=s"(v) : "s"(kp), "n"(I * 8) : "memory");
    return v;
}
template <int I> __device__ __forceinline__ const float* karg() { return (const float*)karg_raw<I>(); }
__device__ __forceinline__ float* kout() { return (float*)karg_raw<26>(); }
__device__ __forceinline__ unsigned char* kws() { return (unsigned char*)karg_raw<27>(); }

__device__ __forceinline__ float wave_sum(float v) {
#pragma unroll
    for (int o = 1; o < 64; o <<= 1) v += __shfl_xor(v, o);
    return v;
}
__device__ __forceinline__ float bf2f(unsigned short b) { return __builtin_bit_cast(float, (unsigned)b << 16); }
__device__ __forceinline__ float bflo(unsigned w) { return __builtin_bit_cast(float, w << 16); }
__device__ __forceinline__ float bfhi(unsigned w) { return __builtin_bit_cast(float, w & 0xffff0000u); }

__device__ __forceinline__ void tr_item(const float* W, int N, bf16* WT, int ldwt, int k0, int n0, int drow0, int dcol0, LAS float* scr, int lane) {
#pragma unroll 8
    for (int i = 0; i < 32; ++i) { const int kk = 2 * i + (lane >> 5); scr[kk * 33 + (lane & 31)] = W[(size_t)(k0 + kk) * N + n0 + (lane & 31)]; }
    LDS_WAIT(); asm volatile("" ::: "memory");
    const int c = lane & 7;
#pragma unroll
    for (int j = 0; j < 4; ++j) { const int n = (lane >> 3) + 8 * j; const LAS float* s = scr + (8 * c) * 33 + n;
        v4u o; o.x = pk2(s[0 * 33], s[1 * 33]); o.y = pk2(s[2 * 33], s[3 * 33]); o.z = pk2(s[4 * 33], s[5 * 33]); o.w = pk2(s[6 * 33], s[7 * 33]);
        *(GAS v4u*)(WT + (size_t)(drow0 + n) * ldwt + dcol0 + k0 + 8 * c) = o; }
    LDS_WAIT(); asm volatile("" ::: "memory");
}
__device__ __forceinline__ void p0_transposes_a(const Ctx& C) {
    LAS float* scr = (LAS float*)(C.lds + RING_OFF + C.wave * 16384);
    const int gw = C.bid * NWAVES + C.wave, NGW = C.G * NWAVES;
    constexpr int I0 = (1024 / 64) * (5632 / 32), I1 = (512 / 64) * (1024 / 32), I2 = (1024 / 64) * (1024 / 32), I3 = I2, I4 = 4 * 2 * 4;
    unsigned char* ws = kws(); const float* w0 = karg<I_WIN>(); const float* w1 = karg<I_WPA>(); const float* w2 = karg<I_WPB>(); const float* w3 = karg<I_WOUT>(); const float* w4 = karg<I_WPOOL>();
    for (int it = gw; it < I0 + I1 + I2 + I3 + I4; it += NGW) {
        int r = it;
        if (r < I0) { const int kb = r / 176, nb = r % 176; tr_item(w0, 5632, (bf16*)(ws + WS_WIN), 1024, 64 * kb, 32 * nb, 32 * nb, 0, scr, C.lane); continue; } r -= I0;
        if (r < I1) { const int kb = r / 32, nb = r % 32; tr_item(w1, 1024, (bf16*)(ws + WS_WPA), 512, 64 * kb, 32 * nb, 32 * nb, 0, scr, C.lane); continue; } r -= I1;
        if (r < I2) { const int kb = r / 32, nb = r % 32; tr_item(w2, 1024, (bf16*)(ws + WS_WPB), 1024, 64 * kb, 32 * nb, 32 * nb, 0, scr, C.lane); continue; } r -= I2;
        if (r < I3) { const int kb = r / 32, nb = r % 32; tr_item(w3, 1024, (bf16*)(ws + WS_WOUT), 1024, 64 * kb, 32 * nb, 32 * nb, 0, scr, C.lane); continue; } r -= I3;
        { const int g = r >> 3, kb = (r >> 2) & 1, nb = r & 3; tr_item(w4 + (size_t)g * 16384, 128, (bf16*)(ws + WS_WPOOLT), 512, 64 * kb, 32 * nb, g * 128 + 32 * nb, g * 128, scr, C.lane); }
    }
    for (int i = C.bid * 512 + C.tid; i < 12 * 128 * 16; i += C.G * 512) { const int blk = i >> 11, rr = (i >> 4) & 127, c8 = (i & 15) * 8; const int gr = blk / 3, gcx = blk % 3, gc = gcx + (gcx >= gr ? 1 : 0);
        *(v4u*)((bf16*)(ws + WS_WPOOLT) + (size_t)(gr * 128 + rr) * 512 + gc * 128 + c8) = (v4u){0u, 0u, 0u, 0u}; }
}
__device__ __forceinline__ void p0_transposes_b(const Ctx& C) {
    LAS float* scr = (LAS float*)(C.lds + RING_OFF + C.wave * 16384);
    const int gw = C.bid * NWAVES + C.wave, NGW = C.G * NWAVES;
    constexpr int I0 = (1024 / 64) * (5632 / 32), I1 = (2816 / 64) * (1024 / 32);
    unsigned char* ws = kws(); const float* w0 = karg<I_WFI>(); const float* w1 = karg<I_WFO>();
    for (int it = gw; it < I0 + I1; it += NGW) {
        int r = it;
        if (r < I0) { const int kb = r / 176, nb = r % 176, n0 = 32 * nb, half = n0 >= 2816, nn = n0 - half * 2816; tr_item(w0, 5632, (bf16*)(ws + WS_WFI), 1024, 64 * kb, n0, (nn >> 7) * 256 + half * 128 + (nn & 127), 0, scr, C.lane); continue; } r -= I0;
        { const int kb = r / 32, nb = r % 32; tr_item(w1, 1024, (bf16*)(ws + WS_WFO), 2816, 64 * kb, 32 * nb, 32 * nb, 0, scr, C.lane); }
    }
}
__device__ __forceinline__ void p0_mod(const Ctx& C) {
    if (C.bid >= 96) return;
    const float* cctx = karg<I_CCTX>(); const float* cc = karg<I_C>(); const float* wada = karg<I_WADA>(); const float* bada = karg<I_BADA>();
    LAS float* s = (LAS float*)(C.lds);
    LAS float* red = s + 9 * 1024;
    for (int i = C.tid; i < 9 * 1024; i += 512) { const int r = i >> 10, k = i & 1023; const float v = r == 0 ? cctx[k] : cc[(r - 1) * 1024 + k]; s[i] = v / (1.0f + __expf(-v)); }
    __syncthreads();
    float* mod = (float*)(kws() + WS_MISC);
    for (int it = C.bid; it < 96; it += C.G) {
        const int n = it * 64 + C.lane, k0 = C.wave * 128; float acc[9];
#pragma unroll
        for (int r = 0; r < 9; ++r) acc[r] = 0.f;
        const float* w = wada + (size_t)k0 * 6144 + n;
#pragma unroll 4
        for (int k = 0; k < 128; ++k) { const float wv = w[(size_t)k * 6144];
#pragma unroll
            for (int r = 0; r < 9; ++r) acc[r] += s[r * 1024 + k0 + k] * wv; }
#pragma unroll
        for (int r = 0; r < 9; ++r) red[(C.wave * 9 + r) * 64 + C.lane] = acc[r];
        __syncthreads();
        for (int i = C.tid; i < 576; i += 512) { const int r = i >> 6, c = i & 63; float t = bada[it * 64 + c];
#pragma unroll
            for (int wv = 0; wv < 8; ++wv) t += red[(wv * 9 + r) * 64 + c];
            mod[r * 6144 + it * 64 + c] = t; }
        __syncthreads();
    }
}
__device__ __forceinline__ void p0_misc(const Ctx& C) {
    unsigned char* ws = kws(); const float* ck = karg<I_CK>(); const float* cv = karg<I_CV>();
    const int gt = C.bid * 512 + C.tid, NT = C.G * 512;
    for (int i = gt; i < 2 * 262144; i += NT) {
        const int which = i >= 262144, j = which ? i - 262144 : i; const int row = j >> 7, c8 = (j & 127) * 8;
        const float* src = (which ? cv : ck) + (size_t)row * 1024 + c8;
        const f32x4 x0 = *(const f32x4*)src, x1 = *(const f32x4*)(src + 4);
        v4u o; o.x = pk2(x0[0], x0[1]); o.y = pk2(x0[2], x0[3]); o.z = pk2(x1[0], x1[1]); o.w = pk2(x1[2], x1[3]);
        const int b = row >> 8, t = row & 255;
        *(v4u*)((bf16*)(ws + (which ? WS_VS : WS_KS)) + (size_t)(b * LKV_S + t) * 1024 + c8) = o;
    }
    if (C.bid == C.G - 1) {
        float* rc = (float*)(ws + WS_MISC + MISC_ROPEC); float* rs = (float*)(ws + WS_MISC + MISC_ROPES);
        for (int i = C.tid; i < 1024; i += 512) { const int pos = i >> 4, f = i & 15; const float inv = powf(10000.0f, -(float)f / 16.0f); const float ang = (float)pos * inv; rc[i] = cosf(ang); rs[i] = sinf(ang); }
        if (C.tid == 0) { const float* q1 = karg<I_LQ1>(); const float* k1 = karg<I_LK1>(); const float* q2 = karg<I_LQ2>(); const float* k2 = karg<I_LK2>(); float s1 = 0.f, s2 = 0.f; for (int i = 0; i < 64; ++i) { s1 += q1[i] * k1[i]; s2 += q2[i] * k2[i]; }
            *(float*)(ws + WS_MISC + MISC_LAM) = expf(s1) - expf(s2) + 0.2f; }
    }
}
__device__ __forceinline__ void modulate_rows(const Ctx& C, const float* xp, const float* xs, const float* g, const float* mod, int shift_off, int scale_off, bf16* H) {
    const int gw = C.bid * NWAVES + C.wave, NGW = C.G * NWAVES;
    for (int row = gw; row < MTOK; row += NGW) {
        const float* xr = row < TOK_P ? xp + (size_t)row * DM : xs + (size_t)(row - TOK_P) * DM;
        const float* mr = mod + (row < TOK_P ? 0 : 1 + ((row - TOK_P) >> 11)) * 6144;
        f32x4 v[4]; float ss = 0.f;
#pragma unroll
        for (int j = 0; j < 4; ++j) { v[j] = *(const f32x4*)(xr + 4 * C.lane + 256 * j); ss += (v[j][0] * v[j][0] + v[j][1] * v[j][1]) + (v[j][2] * v[j][2] + v[j][3] * v[j][3]); }
        const float rstd = 1.0f / sqrtf(wave_sum(ss) * (1.0f / DM) + EPS);
#pragma unroll
        for (int j = 0; j < 4; ++j) { const int c = 4 * C.lane + 256 * j; const f32x4 gg = *(const f32x4*)(g + c), sc = *(const f32x4*)(mr + scale_off + c), sh = *(const f32x4*)(mr + shift_off + c);
            const f32x4 o = v[j] * rstd * gg * (sc + 1.0f) + sh;
            unsigned long long w = (unsigned long long)pk2(o[0], o[1]) | ((unsigned long long)pk2(o[2], o[3]) << 32);
            *(unsigned long long*)(H + (size_t)row * DM + c) = w; }
    }
}
__device__ __forceinline__ void final_norm_rows(const Ctx& C, float* X, const float* g) {
    const int gw = C.bid * NWAVES + C.wave, NGW = C.G * NWAVES;
    for (int row = gw; row < MTOK; row += NGW) {
        float* xr = X + (size_t)row * DM; f32x4 v[4]; float ss = 0.f;
#pragma unroll
        for (int j = 0; j < 4; ++j) { v[j] = *(const f32x4*)(xr + 4 * C.lane + 256 * j); ss += (v[j][0] * v[j][0] + v[j][1] * v[j][1]) + (v[j][2] * v[j][2] + v[j][3] * v[j][3]); }
        const float rstd = 1.0f / sqrtf(wave_sum(ss) * (1.0f / DM) + EPS);
#pragma unroll
        for (int j = 0; j < 4; ++j) { const int c = 4 * C.lane + 256 * j; const f32x4 gg = *(const f32x4*)(g + c); *(f32x4*)(xr + c) = v[j] * rstd * gg; }
    }
}

__device__ __forceinline__ void attn_phase(const Ctx& C) {
    unsigned char* ws = kws(); const float* subln = karg<I_SUBLN>();
    const float lam = __hip_atomic_load((float*)(ws + WS_MISC + MISC_LAM), __ATOMIC_RELAXED, __HIP_MEMORY_SCOPE_AGENT);
    const int vcu = (C.G % 8 == 0) ? (C.bid % 8) * (C.G / 8) + C.bid / 8 : C.bid;
    bf16* Q = (bf16*)(ws + WS_Q);
    for (int u = vcu; u < 1536; u += C.G) {
        bf16* Qrows; const bf16 *Kb, *Vb; int NT, h;
        if (u < 1024) { const int i = u >> 8, v = u & 255, x = v >> 5, c = v & 31, bh = x * 8 + i * 2 + (c >> 4), b = bh >> 3; h = bh & 7;
            Qrows = Q + (size_t)(TOK_P + b * SEQ_S + (c & 15) * 128) * 1024; Kb = (const bf16*)(ws + WS_KS) + (size_t)b * LKV_S * 1024; Vb = (const bf16*)(ws + WS_VS) + (size_t)b * LKV_S * 1024; NT = LKV_S / 64; }
        else { const int j = u - 1024, bh = j >> 1, b = bh >> 3; h = bh & 7;
            Qrows = Q + (size_t)(b * SEQ_P + (j & 1) * 128) * 1024; Kb = (const bf16*)(ws + WS_KP) + (size_t)b * SEQ_P * 1024; Vb = (const bf16*)(ws + WS_VP) + (size_t)b * SEQ_P * 1024; NT = SEQ_P / 64; }
        att::attn_unit<8>(Qrows, Kb, Vb, NT, h, lam, subln, (__attribute__((address_space(3))) char*)C.lds);
    }
}
__device__ __forceinline__ void pooled_rows(const Ctx& C) {
    unsigned char* ws = kws(); const bf16* U = (const bf16*)(ws + WS_U); bf16* PO = (bf16*)(ws + WS_POOLED);
    for (int i = C.bid * 512 + C.tid; i < MTOK * 64; i += C.G * 512) { const int row = i >> 6, c8 = (i & 63) * 8, g = c8 >> 7; int S, t;
        if (row < TOK_P) { S = SEQ_P; t = row & (SEQ_P - 1); } else { S = SEQ_S; t = (row - TOK_P) & (SEQ_S - 1); }
        const int hw = 1 << g, lo = t - hw < 0 ? 0 : t - hw, hi = t + hw > S ? S : t + hw; const bf16* up = U + (size_t)(row - t) * DPOOL + c8;
        float s[8];
#pragma unroll
        for (int j = 0; j < 8; ++j) s[j] = 0.f;
        for (int r = lo; r < hi; ++r) { const v4u w = *(const v4u*)(up + (size_t)r * DPOOL);
            s[0] += bflo(w.x); s[1] += bfhi(w.x); s[2] += bflo(w.y); s[3] += bfhi(w.y); s[4] += bflo(w.z); s[5] += bfhi(w.z); s[6] += bflo(w.w); s[7] += bfhi(w.w); }
        const v4u me = *(const v4u*)(up + (size_t)t * DPOOL); const float inv = 1.0f / (float)(hi - lo);
        v4u o; o.x = pk2(s[0] * inv - bflo(me.x), s[1] * inv - bfhi(me.x)); o.y = pk2(s[2] * inv - bflo(me.y), s[3] * inv - bfhi(me.y));
        o.z = pk2(s[4] * inv - bflo(me.z), s[5] * inv - bfhi(me.z)); o.w = pk2(s[6] * inv - bflo(me.w), s[7] * inv - bfhi(me.w));
        *(v4u*)(PO + (size_t)row * DPOOL + c8) = o; }
}
__device__ __forceinline__ void ffn_fixup(const Ctx& C) {
    unsigned char* ws = kws(); const float* side = (const float*)(ws + WS_SIDE); bf16* ACT = (bf16*)(ws + WS_ACT); const float* cw = karg<I_CONVW>(); const float* cb = karg<I_CONVB>();
    for (int i = C.bid * 512 + C.tid; i < 64 * 2 * 704; i += C.G * 512) { const int c4 = (i % 704) * 4, which = (i / 704) & 1, pm = 32 + i / 1408; const int pn = c4 >> 7, c = c4 & 127;
        if (which == 0 ? ((pm - 32) & 7) == 0 : ((pm - 32) & 7) == 7) continue;
        const float* s0 = side + (size_t)((pm * 22 + pn) * 6) * 128 + c; f32x4 pv, av, nv, uv;
        if (which == 0) { pv = *(const f32x4*)(s0 - (size_t)22 * 6 * 128 + 3 * 128); av = *(const f32x4*)(s0); nv = *(const f32x4*)(s0 + 128); uv = *(const f32x4*)(s0 + 4 * 128); }
        else { pv = *(const f32x4*)(s0 + 2 * 128); av = *(const f32x4*)(s0 + 3 * 128); nv = *(const f32x4*)(s0 + (size_t)22 * 6 * 128); uv = *(const f32x4*)(s0 + 5 * 128); }
        f32x4 cv = *(const f32x4*)(cw + c4) * pv + *(const f32x4*)(cw + 2816 + c4) * av + *(const f32x4*)(cw + 5632 + c4) * nv + *(const f32x4*)(cb + c4);
#pragma unroll
        for (int j = 0; j < 4; ++j) cv[j] = cv[j] / (1.0f + __expf(-cv[j])) * uv[j];
        unsigned long long w = (unsigned long long)pk2(cv[0], cv[1]) | ((unsigned long long)pk2(cv[2], cv[3]) << 32);
        *(unsigned long long*)(ACT + (size_t)(pm * 256 + (which ? 255 : 0)) * DFF + c4) = w; }
}

#ifndef PHASE_MASK
#define PHASE_MASK 0xffffffffu
#endif
#define PH(k) if constexpr (((PHASE_MASK) >> (k)) & 1u)
__global__ void __launch_bounds__(NWAVES * 64, 2) fwd_kernel(Args a_unused) {
    extern __shared__ __attribute__((aligned(16))) unsigned char lds_raw[];
    Ctx C; C.lds = (LAS unsigned char*)lds_raw; C.tid = threadIdx.x; C.lane = C.tid & 63; C.wave = __builtin_amdgcn_readfirstlane(C.tid >> 6); C.G = gridDim.x; C.bid = blockIdx.x;
    volatile LAS unsigned* MISC = (volatile LAS unsigned*)(C.lds + MISC_OFF);
    for (int u = C.tid; u < (LDS_BYTES - LDSCTL_OFF) / 4; u += NWAVES * 64) ((LAS unsigned*)(C.lds + LDSCTL_OFF))[u] = 0u;
    __syncthreads();
    XcdBarrier bar = xcd_barrier_post((unsigned*)(kws() + WS_CTL) + CW_BAR, MISC + 8);
#define GRID_BAR() xcd_barrier(bar)
#define GEMM_PHASE(EPI, Aoff, Boff, MM, NN, KK, ...) { unsigned char* ws = kws(); pg8::Gemm g{(const pg8::bf16_t*)(ws + (Aoff)), (const pg8::bf16_t*)(ws + (Boff)), (MM), (NN), (KK)}; pg8::StaticOrder S; S.init((MM), (NN), C.G, C.bid); \
      EPI E{__VA_ARGS__}; pg8::gemm_phase<EPI, pg8::StaticOrder, true, true>(C.lds + RING_OFF, g, S, E); }

    PH(0) { p0_transposes_a(C); __syncthreads(); p0_mod(C); __syncthreads(); p0_misc(C); }
    GRID_BAR();
    PH(1) { unsigned char* ws = kws(); modulate_rows(C, karg<I_XP>(), karg<I_XS>(), karg<I_N1>(), (const float*)(ws + WS_MISC), 0, 1024, (bf16*)(ws + WS_H)); }
    GRID_BAR();
    PH(2) GEMM_PHASE(pg8::EpiProj, WS_H, WS_WIN, MTOK, DIN, DM, ws, kout())
    GRID_BAR();
    PH(3) pooled_rows(C);
    GRID_BAR();
    PH(4) GEMM_PHASE(pg8::EpiPoolMix, WS_POOLED, WS_WPOOLT, MTOK, DPOOL, DPOOL, (bf16*)(ws + WS_MIXED), karg<I_PSCALE>())
    PH(5) attn_phase(C);
    GRID_BAR();
    PH(6) GEMM_PHASE(pg8::EpiGate<0>, WS_MIXED, WS_WPA, MTOK, DM, DPOOL, (bf16*)(ws + WS_MERGED), (const bf16*)kout())
    PH(7) GEMM_PHASE(pg8::EpiGate<1>, WS_Q, WS_WPB, MTOK, DM, DM, (bf16*)(ws + WS_MERGED), (const bf16*)kout())
    GRID_BAR();
    PH(8) GEMM_PHASE(pg8::EpiResid, WS_MERGED, WS_WOUT, MTOK, DM, DM, karg<I_XP>(), karg<I_XS>(), kout(), (const float*)(ws + WS_MISC), 2048, 0)
    GRID_BAR();
    PH(9) { unsigned char* ws = kws(); float* X = kout(); modulate_rows(C, X, X + (size_t)TOK_P * DM, karg<I_N2>(), (const float*)(ws + WS_MISC), 3072, 4096, (bf16*)(ws + WS_H)); __syncthreads(); p0_transposes_b(C); }
    GRID_BAR();
    PH(10) GEMM_PHASE(pg8::EpiFfn, WS_H, WS_WFI, MTOK, DIN, DM, (bf16*)(ws + WS_ACT), karg<I_CONVW>(), karg<I_CONVB>(), (float*)(ws + WS_SIDE), (PG8_LAS float*)(C.lds + LDS_EDGE_OFF))
    GRID_BAR();
    PH(11) ffn_fixup(C);
    GRID_BAR();
    PH(12) { float* X = kout(); GEMM_PHASE(pg8::EpiResid, WS_ACT, WS_WFO, MTOK, DM, DFF, X, X + (size_t)TOK_P * DM, X, (const float*)(ws + WS_MISC), 5120, 0) }
    GRID_BAR();
    PH(13) final_norm_rows(C, kout(), karg<I_FN>());
}

extern "C" void kernel_launch(void* const* d_in, const int* in_sizes, int n_in, void* d_out, int out_size, void* d_ws, size_t ws_size, hipStream_t stream) {
    static int grid = 0;
    if (grid == 0) {
        if (n_in != 26 || in_sizes[0] != TOK_P * DM || out_size != 41943040 || ws_size < WS_END) { fprintf(stderr, "kernel_launch: unexpected shapes: n_in %d in0 %d out %d ws %zu; nothing launched\n", n_in, n_in > 0 ? in_sizes[0] : -1, out_size, ws_size); grid = -1; return; }
        int dev = 0, cus = 0, per_cu = 0;
        if (hipGetDevice(&dev) != hipSuccess || hipDeviceGetAttribute(&cus, hipDeviceAttributeMultiprocessorCount, dev) != hipSuccess) { grid = -1; return; }
        if (hipFuncSetAttribute((const void*)fwd_kernel, hipFuncAttributeMaxDynamicSharedMemorySize, LDS_BYTES) != hipSuccess) { fprintf(stderr, "kernel_launch: hipFuncSetAttribute failed\n"); grid = -1; return; }
        if (hipOccupancyMaxActiveBlocksPerMultiprocessor(&per_cu, (const void*)fwd_kernel, NWAVES * 64, LDS_BYTES) != hipSuccess || per_cu < 1) fprintf(stderr, "kernel_launch: note: occupancy query reports %d\n", per_cu);
        (void)hipGetLastError();
        grid = cus;
    }
    if (grid < 0) return;
    if (hipMemsetAsync((char*)d_ws + WS_CTL, 0, CTL_ZERO_BYTES, stream) != hipSuccess) return;
    Args a{};
    for (int i = 0; i < 26; ++i) a.in[i] = (const float*)d_in[i];
    a.out = (float*)d_out; a.ws = (unsigned char*)d_ws;
    hipLaunchKernelGGL(fwd_kernel, dim3(grid), dim3(NWAVES * 64), LDS_BYTES, stream, a);
}
```

```cpp
#include <hip/hip_runtime.h>
#include <cstdio>
#include <cstdint>

constexpr int NWAVES = 8;
constexpr int DM = 1024, TOK_P = 8192, TOK_S = 16384, MTOK = 24576, SEQ_P = 256, SEQ_S = 2048, LKV_S = 2304;
constexpr int DIN = 5632, DFF = 2816, DPOOL = 512;
constexpr float EPS = 1e-6f;
constexpr float QSCALE = 0.125f * 1.4426950408889634f;
constexpr size_t MiB = 1u << 20;
constexpr size_t WS_CTL = 0, CTL_ZERO_BYTES = 1 * MiB;
constexpr size_t WS_MISC = 1 * MiB;
constexpr size_t MISC_ROPEC = 256 * 1024, MISC_ROPES = 260 * 1024, MISC_LAM = 320 * 1024;
constexpr size_t WS_WIN = 2 * MiB, WS_WPA = 13 * MiB, WS_WPB = 14 * MiB, WS_WOUT = 16 * MiB;
constexpr size_t WS_H = 18 * MiB;
constexpr size_t WS_U = 66 * MiB;
constexpr size_t WS_Q = 90 * MiB;
constexpr size_t WS_KP = 138 * MiB, WS_KS = 154 * MiB;
constexpr size_t WS_VP = 190 * MiB, WS_VS = 206 * MiB;
constexpr size_t WS_END = 242 * MiB;
constexpr size_t WS_MIXED = WS_H, WS_POOLED = WS_H + 24 * MiB, WS_MERGED = WS_KP;
constexpr size_t WS_WPOOLT = WS_MISC + 512 * 1024;
constexpr size_t WS_WFI = WS_U, WS_WFO = WS_U + 11 * MiB;
constexpr size_t WS_ACT = WS_Q, WS_SIDE = 222 * MiB;
static_assert(WS_ACT + (size_t)24576 * 2816 * 2 <= WS_SIDE && WS_SIDE + (size_t)96 * 22 * 6 * 128 * 4 <= WS_END, "ffn buffers");
constexpr int CW_TMO = 0, CW_CODE = 1, CW_BAR = 4096;
constexpr size_t OUT_K = 25165824, OUT_V = 33554432;
constexpr int RING_OFF = 0, RING_BYTES = 131072;
constexpr int LDSCTL_OFF = RING_BYTES, MISC_OFF = LDSCTL_OFF + 320;
constexpr int LDS_EDGE_OFF = LDSCTL_OFF + 1024;
constexpr int LDS_BYTES = 147456;

namespace pg8 {
#define PG8_LAS __attribute__((address_space(3)))
typedef unsigned short bf16_t;
typedef short bf16x8 __attribute__((ext_vector_type(8)));
typedef float f32x4 __attribute__((ext_vector_type(4)));
typedef unsigned u32x4 __attribute__((ext_vector_type(4)));
constexpr int BM = 256, BK = 64, HALF = 128, HTB = HALF * BK * 2  , STAGE_BYTES = 8 * HTB, NXCD = 8, WGM = 8;

__host__ __device__ __forceinline__ int lds_byte(int r, int c) { const int st = (r >> 4) * 2 + (c >> 5), rr = r & 15, cc = c & 31, ob = rr * 64 + cc * 2; return st * 1024 + (ob ^ (((ob >> 9) & 1) << 5)); }
__host__ __device__ __forceinline__ void stage_rc(int b, int& R, int& C) { const int st = b / 1024, sb = b % 1024, swz = sb ^ (((sb >> 9) & 1) << 5); R = (st >> 1) * 16 + swz / 64; C = (st & 1) * 32 + (swz % 64) / 2; }
__host__ __device__ __forceinline__ int perm32(int rho) { const int n = rho >> 4, i = rho & 15; return 8 * (i >> 2) + 4 * n + (i & 3); }

struct Unit { int pm, pn; };
struct Gemm { const bf16_t* A; const bf16_t* Bt; int M, N, K; };

struct StaticOrder {
    int nM, nN, nwg, G, c;
    __host__ __device__ void init(int M, int N, int G_, int c_) { nM = M / BM; nN = N / BM; nwg = nM * nN; G = G_; c = c_; }
    __host__ __device__ bool next(int i, Unit& u) const {
        const long L = (long)i * G + c; if (L >= nwg) return false;
        int wgid = (int)L; { const int q = nwg / NXCD, r = nwg % NXCD, xcd = wgid % NXCD, off = wgid / NXCD; wgid = (xcd < r ? xcd * (q + 1) : r * (q + 1) + (xcd - r) * q) + off; }
        const int nig = WGM * nN, gid = wgid / nig, fm = gid * WGM, gsz = (nM - fm) < WGM ? (nM - fm) : WGM;
        u.pm = fm + ((wgid % nig) % gsz); u.pn = (wgid % nig) / gsz; return true;
    }
    __device__ __forceinline__ void a_ready(const Unit&) const {}
    __device__ __forceinline__ void done(const Unit&) const {}
};


__device__ __forceinline__ unsigned cvt_pk_bf16(float lo, float hi) { unsigned r; asm volatile("v_cvt_pk_bf16_f32 %0, %1, %2" : "=v"(r) : "v"(lo), "v"(hi)); return r; }

typedef unsigned u32x2 __attribute__((ext_vector_type(2)));
__device__ __forceinline__ u32x2 pack4(const f32x4 v) { u32x2 w; w.x = cvt_pk_bf16(v[0], v[1]); w.y = cvt_pk_bf16(v[2], v[3]); return w; }

struct EpiStoreBf16 {
    static constexpr bool PERM = false, AFTER_DRAIN = false;
    bf16_t* O; int ldc;
    __device__ __forceinline__ void operator()(f32x4 (&acc)[2][2][4][2], const Unit& u, int wr, int wc, int fr, int fq) const {
#pragma unroll
        for (int ai = 0; ai < 2; ++ai)
#pragma unroll
            for (int m = 0; m < 4; ++m) { bf16_t* rowp = O + (size_t)(u.pm * BM + ai * HALF + wr * 64 + m * 16 + fr) * ldc + u.pn * BM + wc * 32 + 4 * fq;
#pragma unroll
                for (int bj = 0; bj < 2; ++bj)
#pragma unroll
                    for (int n = 0; n < 2; ++n) *(u32x2*)(rowp + bj * HALF + n * 16) = pack4(acc[ai][bj][m][n]); }
    }
};

struct EpiResid {
    static constexpr bool PERM = false, AFTER_DRAIN = false;
    const float* xin_p; const float* xin_s; float* out; const float* mod; int goff; int row_base;
    __device__ __forceinline__ void operator()(f32x4 (&acc)[2][2][4][2], const Unit& u, int wr, int wc, int fr, int fq) const {
        const int grow0 = row_base + u.pm * BM; const bool smp = grow0 >= 8192;
        const int col0 = u.pn * BM + wc * 32 + 4 * fq;
        const float* xin = (smp ? xin_s + (size_t)(grow0 - 8192) * 1024 : xin_p + (size_t)grow0 * 1024) + col0;
        const float* gate = mod + (smp ? 1 + ((grow0 - 8192) >> 11) : 0) * 6144 + goff + col0;
        float* o = out + (size_t)grow0 * 1024 + col0;
        f32x4 g[2][2];
#pragma unroll
        for (int bj = 0; bj < 2; ++bj)
#pragma unroll
            for (int n = 0; n < 2; ++n) g[bj][n] = *(const f32x4*)(gate + bj * HALF + n * 16);
#pragma unroll
        for (int ai = 0; ai < 2; ++ai)
#pragma unroll
            for (int m = 0; m < 4; ++m) { int rl = ai * HALF + wr * 64 + m * 16 + fr; asm volatile("" : "+v"(rl)); const size_t off = (size_t)rl * 1024;
#pragma unroll
                for (int bj = 0; bj < 2; ++bj)
#pragma unroll
                    for (int n = 0; n < 2; ++n) { const f32x4 x = *(const f32x4*)(xin + off + bj * HALF + n * 16); *(f32x4*)(o + off + bj * HALF + n * 16) = x + g[bj][n] * acc[ai][bj][m][n]; }
                if (m & 1) asm volatile("" ::: "memory"); }
    }
};

__device__ __forceinline__ u32x4 pack8(const f32x4 a, const f32x4 b) { u32x4 w; w.x = cvt_pk_bf16(a[0], a[1]); w.y = cvt_pk_bf16(a[2], a[3]); w.z = cvt_pk_bf16(b[0], b[1]); w.w = cvt_pk_bf16(b[2], b[3]); return w; }
__device__ __forceinline__ f32x4 unpack4(const u32x2 w) { f32x4 v; v[0] = __builtin_bit_cast(float, w.x << 16); v[1] = __builtin_bit_cast(float, w.x & 0xffff0000u); v[2] = __builtin_bit_cast(float, w.y << 16); v[3] = __builtin_bit_cast(float, w.y & 0xffff0000u); return v; }
__device__ __forceinline__ float lane_xor32(float x, int hi) { auto r = __builtin_amdgcn_permlane32_swap(__builtin_bit_cast(unsigned, x), __builtin_bit_cast(unsigned, x), false, false); return __builtin_bit_cast(float, hi ? r[0] : r[1]); }

struct EpiProj {
    static constexpr bool PERM = true, AFTER_DRAIN = false;
    unsigned char* ws; float* out;
    __device__ __forceinline__ void operator()(f32x4 (&acc)[2][2][4][2], const Unit& u, int wr, int wc, int fr, int fq) const {
        const int pn = u.pn, grow0 = u.pm * BM; const bool smp = u.pm >= 32;
        const int sb = (grow0 - 8192) >> 11, st0 = (grow0 - 8192) & 2047;
        const size_t kvrow = smp ? (size_t)(sb * 2304 + 256 + st0) : (size_t)grow0;
        bf16_t* d16; int ld16; float* d32 = nullptr;
        if (pn < 2)       { d16 = (bf16_t*)(ws + WS_U) + (size_t)grow0 * 512 + pn * BM; ld16 = 512; }
        else if (pn < 6)  { d16 = (bf16_t*)(ws + WS_Q) + (size_t)grow0 * 1024 + (pn - 2) * BM; ld16 = 1024; }
        else if (pn < 10) { d16 = (bf16_t*)(ws + (smp ? WS_KS : WS_KP)) + kvrow * 1024 + (pn - 6) * BM; ld16 = 1024; if (!smp) d32 = out + OUT_K + (size_t)grow0 * 1024 + (pn - 6) * BM; }
        else if (pn < 14) { d16 = (bf16_t*)(ws + (smp ? WS_VS : WS_VP)) + kvrow * 1024 + (pn - 10) * BM; ld16 = 1024; if (!smp) d32 = out + OUT_V + (size_t)grow0 * 1024 + (pn - 10) * BM; }
        else              { d16 = (bf16_t*)out + (size_t)grow0 * 2048 + (pn - 14) * BM; ld16 = 2048; }
        const bool do_rope = smp && pn >= 2 && pn < 10, do_sig = pn >= 14, do_qs = pn >= 2 && pn < 6;
        const int hi = fq >> 1; const float sgn = hi ? 1.0f : -1.0f;
        const float* ropeC = (const float*)(ws + WS_MISC + MISC_ROPEC) + 8 * (fq & 1); const float* ropeS = (const float*)(ws + WS_MISC + MISC_ROPES) + 8 * (fq & 1);
#pragma unroll
        for (int ai = 0; ai < 2; ++ai)
#pragma unroll
            for (int m = 0; m < 4; ++m) { int rl = ai * HALF + wr * 64 + m * 16 + fr; asm volatile("" : "+v"(rl));
                f32x4 v[2][2];
#pragma unroll
                for (int bj = 0; bj < 2; ++bj)
#pragma unroll
                    for (int n = 0; n < 2; ++n) v[bj][n] = acc[ai][bj][m][n];
                if (do_rope) { const int t = st0 + rl; const int pos = (wc & 1) ? (t & 63) : (t >> 6);
#pragma unroll
                    for (int n = 0; n < 2; ++n) { const f32x4 c4 = *(const f32x4*)(ropeC + pos * 16 + 4 * n), s4 = *(const f32x4*)(ropeS + pos * 16 + 4 * n) * sgn;
#pragma unroll
                        for (int bj = 0; bj < 2; ++bj) { f32x4 oth;
#pragma unroll
                            for (int i = 0; i < 4; ++i) oth[i] = lane_xor32(v[bj][n][i], hi);
                            v[bj][n] = v[bj][n] * c4 + oth * s4; } } }
                if (do_qs) {
#pragma unroll
                    for (int bj = 0; bj < 2; ++bj)
#pragma unroll
                        for (int n = 0; n < 2; ++n) v[bj][n] = v[bj][n] * QSCALE; }
                if (do_sig) {
#pragma unroll
                    for (int bj = 0; bj < 2; ++bj)
#pragma unroll
                        for (int n = 0; n < 2; ++n)
#pragma unroll
                            for (int i = 0; i < 4; ++i) v[bj][n][i] = __builtin_amdgcn_rcpf(1.0f + __expf(-v[bj][n][i])); }
                bf16_t* rowp = d16 + (size_t)rl * ld16 + wc * 32 + 8 * fq;
#pragma unroll
                for (int bj = 0; bj < 2; ++bj) *(u32x4*)(rowp + bj * HALF) = pack8(v[bj][0], v[bj][1]);
                if (d32) { float* rp = d32 + (size_t)rl * 1024 + wc * 32 + 8 * fq;
#pragma unroll
                    for (int bj = 0; bj < 2; ++bj) { *(f32x4*)(rp + bj * HALF) = v[bj][0]; *(f32x4*)(rp + bj * HALF + 4) = v[bj][1]; } }
                asm volatile("" ::: "memory"); }
    }
};

struct EpiPoolMix {
    static constexpr bool PERM = true, AFTER_DRAIN = false;
    bf16_t* O; const float* ps;
    __device__ __forceinline__ void operator()(f32x4 (&acc)[2][2][4][2], const Unit& u, int wr, int wc, int fr, int fq) const {
        const int col0 = u.pn * BM + wc * 32 + 8 * fq; f32x4 s[2][2];
#pragma unroll
        for (int bj = 0; bj < 2; ++bj)
#pragma unroll
            for (int n = 0; n < 2; ++n) s[bj][n] = *(const f32x4*)(ps + col0 + bj * HALF + n * 4);
#pragma unroll
        for (int ai = 0; ai < 2; ++ai)
#pragma unroll
            for (int m = 0; m < 4; ++m) { int rl = ai * HALF + wr * 64 + m * 16 + fr; asm volatile("" : "+v"(rl)); bf16_t* rowp = O + (size_t)(u.pm * BM + rl) * 512 + col0;
#pragma unroll
                for (int bj = 0; bj < 2; ++bj) *(u32x4*)(rowp + bj * HALF) = pack8(acc[ai][bj][m][0] * s[bj][0], acc[ai][bj][m][1] * s[bj][1]); }
    }
};
template <int SECOND> struct EpiGate {
    static constexpr bool PERM = true, AFTER_DRAIN = false;
    bf16_t* MG; const bf16_t* G;
    __device__ __forceinline__ void operator()(f32x4 (&acc)[2][2][4][2], const Unit& u, int wr, int wc, int fr, int fq) const {
        const int col0 = u.pn * BM + wc * 32 + 8 * fq;
#pragma unroll
        for (int ai = 0; ai < 2; ++ai)
#pragma unroll
            for (int m = 0; m < 4; ++m) { int rl = ai * HALF + wr * 64 + m * 16 + fr; asm volatile("" : "+v"(rl)); const size_t row = (size_t)(u.pm * BM + rl);
                const bf16_t* gp = G + row * 2048 + SECOND * 1024 + col0; bf16_t* mp = MG + row * 1024 + col0;
#pragma unroll
                for (int bj = 0; bj < 2; ++bj) { const u32x4 gw = *(const u32x4*)(gp + bj * HALF);
                    f32x4 r0 = unpack4((u32x2){gw.x, gw.y}) * acc[ai][bj][m][0], r1 = unpack4((u32x2){gw.z, gw.w}) * acc[ai][bj][m][1];
                    if (SECOND) { const u32x4 ow = *(const u32x4*)(mp + bj * HALF); r0 = r0 + unpack4((u32x2){ow.x, ow.y}); r1 = r1 + unpack4((u32x2){ow.z, ow.w}); }
                    *(u32x4*)(mp + bj * HALF) = pack8(r0, r1); }
                asm volatile("" ::: "memory"); }
    }
};
__device__ __forceinline__ float dpp_ror1_s(float x) { return __builtin_bit_cast(float, __builtin_amdgcn_update_dpp(0, __builtin_bit_cast(int, x), 0x121, 0xf, 0xf, false)); }
__device__ __forceinline__ float dpp_ror15_s(float x) { return __builtin_bit_cast(float, __builtin_amdgcn_update_dpp(0, __builtin_bit_cast(int, x), 0x12f, 0xf, 0xf, false)); }
__device__ __forceinline__ f32x4 dpp_ror1(const f32x4 v) { const float a = dpp_ror1_s(v[0]), b = dpp_ror1_s(v[1]), c = dpp_ror1_s(v[2]), d = dpp_ror1_s(v[3]); return (f32x4){a, b, c, d}; }
__device__ __forceinline__ f32x4 dpp_ror15(const f32x4 v) { const float a = dpp_ror15_s(v[0]), b = dpp_ror15_s(v[1]), c = dpp_ror15_s(v[2]), d = dpp_ror15_s(v[3]); return (f32x4){a, b, c, d}; }
struct EpiFfn {
    static constexpr bool PERM = true, AFTER_DRAIN = false;
    bf16_t* ACT; const float* cw; const float* cb; float* side; PG8_LAS float* edge;
    __device__ __forceinline__ void operator()(f32x4 (&acc)[2][2][4][2], const Unit& u, int wr, int wc, int fr, int fq) const {
        const int c128 = wc * 32 + 8 * fq;
#pragma unroll
        for (int ai = 0; ai < 2; ++ai) { const int rb = 2 * ai + wr;
            if (fr == 0) {
#pragma unroll
                for (int n = 0; n < 2; ++n) *(PG8_LAS f32x4*)(edge + (rb * 2 + 0) * 128 + c128 + 4 * n) = acc[ai][0][0][n]; }
            if (fr == 15) {
#pragma unroll
                for (int n = 0; n < 2; ++n) *(PG8_LAS f32x4*)(edge + (rb * 2 + 1) * 128 + c128 + 4 * n) = acc[ai][0][3][n]; } }
        if (u.pm >= 32) { float* sb = side + (size_t)((u.pm * 22 + u.pn) * 6) * 128 + c128;
            if (wr == 0) {
                if (fr == 0) {
#pragma unroll
                    for (int n = 0; n < 2; ++n) { *(f32x4*)(sb + 0 * 128 + 4 * n) = acc[0][0][0][n]; *(f32x4*)(sb + 4 * 128 + 4 * n) = acc[0][1][0][n]; } }
                if (fr == 1) {
#pragma unroll
                    for (int n = 0; n < 2; ++n) *(f32x4*)(sb + 1 * 128 + 4 * n) = acc[0][0][0][n]; }
            } else {
                if (fr == 14) {
#pragma unroll
                    for (int n = 0; n < 2; ++n) *(f32x4*)(sb + 2 * 128 + 4 * n) = acc[1][0][3][n]; }
                if (fr == 15) {
#pragma unroll
                    for (int n = 0; n < 2; ++n) { *(f32x4*)(sb + 3 * 128 + 4 * n) = acc[1][0][3][n]; *(f32x4*)(sb + 5 * 128 + 4 * n) = acc[1][1][3][n]; } }
            } }
        asm volatile("s_waitcnt lgkmcnt(0)" ::: "memory"); __builtin_amdgcn_s_barrier(); asm volatile("" ::: "memory");
        const f32x4 zero4 = (f32x4){0.f, 0.f, 0.f, 0.f};
        const int gcol = u.pn * 128 + c128;
        f32x4 w0[2], w1[2], w2[2], bb[2];
#pragma unroll
        for (int n = 0; n < 2; ++n) { w0[n] = *(const f32x4*)(cw + gcol + 4 * n); w1[n] = *(const f32x4*)(cw + 2816 + gcol + 4 * n); w2[n] = *(const f32x4*)(cw + 5632 + gcol + 4 * n); bb[n] = *(const f32x4*)(cb + gcol + 4 * n); }
#pragma unroll
        for (int ai = 0; ai < 2; ++ai) { const int rb = 2 * ai + wr;
            f32x4 pc[2], en[2];
#pragma unroll
            for (int n = 0; n < 2; ++n) { pc[n] = rb > 0 ? *(const PG8_LAS f32x4*)(edge + ((rb - 1) * 2 + 1) * 128 + c128 + 4 * n) : zero4; en[n] = rb < 3 ? *(const PG8_LAS f32x4*)(edge + ((rb + 1) * 2 + 0) * 128 + c128 + 4 * n) : zero4; }
#pragma unroll
            for (int m = 0; m < 4; ++m) { int rl = ai * HALF + wr * 64 + m * 16 + fr; asm volatile("" : "+v"(rl));
                f32x4 res[2];
#pragma unroll
                for (int n = 0; n < 2; ++n) {
                    const f32x4 a = acc[ai][0][m][n]; const f32x4 Pm = dpp_ror1(a), Nm = dpp_ror15(a);
                    const f32x4 nx = m < 3 ? dpp_ror15(acc[ai][0][m < 3 ? m + 1 : 3][n]) : en[n];
                    const f32x4 prev = fr == 0 ? pc[n] : Pm, next = fr == 15 ? nx : Nm; pc[n] = Pm;
                    f32x4 cv = w0[n] * prev + w1[n] * a + w2[n] * next + bb[n];
#pragma unroll
                    for (int i = 0; i < 4; ++i) cv[i] = cv[i] * __builtin_amdgcn_rcpf(1.0f + __expf(-cv[i]));
                    res[n] = cv * acc[ai][1][m][n]; }
                *(u32x4*)(ACT + (size_t)(u.pm * BM + rl) * 2816 + gcol) = pack8(res[0], res[1]); } }
    }
};

template <class Epi, class Sched, bool ALIGN_EPI = false, bool SP2 = false>
__device__ __forceinline__ void gemm_phase(PG8_LAS unsigned char* lds, const Gemm g, const Sched& S, const Epi& E) {
    int tid_ = threadIdx.x; asm volatile("" : "+v"(tid_));
    const int tid = tid_, wid = __builtin_amdgcn_readfirstlane(tid >> 6), lane = tid & 63, wr = wid >> 2, wc = wid & 3, fr = lane & 15, fq = lane >> 4;
    const int K = g.K, nt = K / BK;
    unsigned voffA[2], voffB[2];
#pragma unroll
    for (int i = 0; i < 2; ++i) { int R, C; stage_rc(tid * 16 + i * 8192, R, C); const int Rb = Epi::PERM ? ((R & ~31) + perm32(R & 31)) : R;
        voffA[i] = (unsigned)(R * K + C) * 2u; voffB[i] = (unsigned)(Rb * K + C) * 2u; }
    const size_t kstep = (size_t)(BK * 2);
    const size_t hstep = (size_t)HALF * K * 2;
    const size_t tstep = 2 * hstep;
    const unsigned ldsw = (unsigned)wid * 1024u;
    const int aoff = lds_byte(wr * 64 + fr, fq * 8), boff = lds_byte(wc * 32 + fr, fq * 8);
#define PG8_SA(b, h) (((b) * 2 + (h)) * HTB)
#define PG8_SB(b, h) ((4 + (b) * 2 + (h)) * HTB)
#define PG8_STAGE(bufoff, gbase, voff) do { _Pragma("unroll") for (int _i = 0; _i < 2; ++_i) \
        __builtin_amdgcn_global_load_lds((const unsigned*)((const char*)(gbase) + (voff)[_i]), (PG8_LAS unsigned*)(lds + (bufoff) + ldsw + _i * 8192), 16, 0, 0); } while (0)
#define PG8_LDA(dst, b, h) do { _Pragma("unroll") for (int m = 0; m < 4; ++m) _Pragma("unroll") for (int k = 0; k < 2; ++k) dst[m][k] = *(const PG8_LAS bf16x8*)(lds + PG8_SA(b, h) + aoff + m * 2048 + k * 1024); } while (0)
#define PG8_LDB(dst, b, h) do { _Pragma("unroll") for (int n = 0; n < 2; ++n) _Pragma("unroll") for (int k = 0; k < 2; ++k) dst[n][k] = *(const PG8_LAS bf16x8*)(lds + PG8_SB(b, h) + boff + n * 2048 + k * 1024); } while (0)
#define PG8_MMA(ai, bj, At, Bt) do { __builtin_amdgcn_s_setprio(1); _Pragma("unroll") for (int m = 0; m < 4; ++m) _Pragma("unroll") for (int n = 0; n < 2; ++n) _Pragma("unroll") for (int k = 0; k < 2; ++k) \
        acc[ai][bj][m][n] = __builtin_amdgcn_mfma_f32_16x16x32_bf16(Bt[n][k], At[m][k], acc[ai][bj][m][n], 0, 0, 0); __builtin_amdgcn_s_setprio(0); } while (0)
#define PG8_WAIT_V(n) asm volatile("s_waitcnt vmcnt(" #n ")" ::: "memory")
#define PG8_WAIT_L(n) asm volatile("s_waitcnt lgkmcnt(" #n ")" ::: "memory")
#define PG8_BAR __builtin_amdgcn_s_barrier()
#define PG8_SCHED __builtin_amdgcn_sched_barrier(0)
    Unit cur, nxt; int ui = 0;
    if (!S.next(0, cur)) return;
    f32x4 acc[2][2][4][2];
#pragma unroll
    for (int a = 0; a < 2; ++a)
#pragma unroll
        for (int b = 0; b < 2; ++b)
#pragma unroll
            for (int m = 0; m < 4; ++m)
#pragma unroll
                for (int n = 0; n < 2; ++n) acc[a][b][m][n] = (f32x4){0.f, 0.f, 0.f, 0.f};
    bf16x8 At[4][2], B0[2][2], B1[2][2];
    const char* cA = (const char*)g.A + (size_t)cur.pm * tstep; const char* cB = (const char*)g.Bt + (size_t)cur.pn * tstep;
    S.a_ready(cur);
    if constexpr (SP2) {
        PG8_STAGE(PG8_SB(0, 0), cB, voffB); PG8_STAGE(PG8_SB(0, 1), cB + hstep, voffB); PG8_STAGE(PG8_SA(0, 0), cA, voffA); PG8_STAGE(PG8_SA(0, 1), cA + hstep, voffA);
        if (wr == 1) PG8_BAR;
        PG8_WAIT_V(2); PG8_BAR;
        PG8_STAGE(PG8_SB(1, 0), cB + kstep, voffB); PG8_STAGE(PG8_SA(1, 0), cA + kstep, voffA); PG8_STAGE(PG8_SB(1, 1), cB + hstep + kstep, voffB);
        PG8_WAIT_V(6); PG8_BAR;
    } else {
        PG8_STAGE(PG8_SB(0, 0), cB, voffB); PG8_STAGE(PG8_SA(0, 0), cA, voffA); PG8_STAGE(PG8_SB(0, 1), cB + hstep, voffB); PG8_STAGE(PG8_SA(0, 1), cA + hstep, voffA);
        if (wr == 1) PG8_BAR;
        PG8_WAIT_V(4); PG8_BAR;
        PG8_STAGE(PG8_SB(1, 0), cB + kstep, voffB); PG8_STAGE(PG8_SA(1, 0), cA + kstep, voffA); PG8_STAGE(PG8_SB(1, 1), cB + hstep + kstep, voffB);
        PG8_WAIT_V(6); PG8_BAR;
    }
    for (;;) {
        const bool has_next = S.next(ui + 1, nxt);
        const char* nA = has_next ? (const char*)g.A + (size_t)nxt.pm * tstep : cA; const char* nB = has_next ? (const char*)g.Bt + (size_t)nxt.pn * tstep : cB;
        for (int t = 0; t < nt; t += 2) {
            const bool last = (t == nt - 2);
            const char* a1 = cA + (size_t)(t + 1) * kstep;
            const char* a2 = last ? nA : cA + (size_t)(t + 2) * kstep; const char* b2 = last ? nB : cB + (size_t)(t + 2) * kstep;
            const char* a3 = a2 + kstep; const char* b3 = b2 + kstep;
            if (last && has_next) S.a_ready(nxt);
            if constexpr (SP2) {
            PG8_LDB(B0, 0, 0); PG8_LDB(B1, 0, 1); PG8_SCHED; PG8_LDA(At, 0, 0); PG8_STAGE(PG8_SA(1, 1), a1 + hstep, voffA);
            PG8_WAIT_V(8); PG8_WAIT_L(0); PG8_BAR; PG8_MMA(0, 0, At, B0); PG8_MMA(0, 1, At, B1); PG8_BAR; PG8_SCHED;
            PG8_LDA(At, 0, 1); PG8_STAGE(PG8_SB(0, 0), b2, voffB); PG8_STAGE(PG8_SB(0, 1), b2 + hstep, voffB); PG8_STAGE(PG8_SA(0, 0), a2, voffA);
            PG8_WAIT_V(8); PG8_WAIT_L(0); PG8_BAR; PG8_MMA(1, 0, At, B0); PG8_MMA(1, 1, At, B1); PG8_BAR; PG8_SCHED;
            PG8_LDB(B0, 1, 0); PG8_LDB(B1, 1, 1); PG8_SCHED; PG8_LDA(At, 1, 0); PG8_STAGE(PG8_SA(0, 1), a2 + hstep, voffA);
            PG8_WAIT_V(8); PG8_WAIT_L(0); PG8_BAR; PG8_MMA(0, 0, At, B0); PG8_MMA(0, 1, At, B1); PG8_BAR; PG8_SCHED;
            PG8_LDA(At, 1, 1); PG8_STAGE(PG8_SB(1, 0), b3, voffB); PG8_STAGE(PG8_SB(1, 1), b3 + hstep, voffB); PG8_STAGE(PG8_SA(1, 0), a3, voffA);
            PG8_WAIT_V(8); PG8_WAIT_L(0); PG8_BAR; PG8_MMA(1, 0, At, B0); PG8_MMA(1, 1, At, B1); PG8_BAR; PG8_SCHED;
            } else {
            PG8_LDB(B0, 0, 0); PG8_SCHED; PG8_LDA(At, 0, 0); PG8_STAGE(PG8_SA(1, 1), a1 + hstep, voffA);
            PG8_WAIT_L(8); PG8_BAR; PG8_WAIT_L(0); PG8_MMA(0, 0, At, B0); PG8_BAR; PG8_SCHED;
            PG8_LDB(B1, 0, 1); PG8_STAGE(PG8_SB(0, 0), b2, voffB);
            PG8_BAR; PG8_WAIT_L(0); PG8_MMA(0, 1, At, B1); PG8_BAR;
            PG8_LDA(At, 0, 1); PG8_STAGE(PG8_SA(0, 0), a2, voffA);
            PG8_BAR; PG8_WAIT_L(0); PG8_MMA(1, 0, At, B0); PG8_BAR; PG8_SCHED;
            PG8_STAGE(PG8_SB(0, 1), b2 + hstep, voffB);
            PG8_WAIT_V(6); PG8_BAR; PG8_MMA(1, 1, At, B1); PG8_BAR;
            PG8_LDB(B0, 1, 0); PG8_SCHED; PG8_LDA(At, 1, 0); PG8_STAGE(PG8_SA(0, 1), a2 + hstep, voffA);
            PG8_WAIT_L(8); PG8_BAR; PG8_WAIT_L(0); PG8_MMA(0, 0, At, B0); PG8_BAR; PG8_SCHED;
            PG8_LDB(B1, 1, 1); PG8_STAGE(PG8_SB(1, 0), b3, voffB);
            PG8_BAR; PG8_WAIT_L(0); PG8_MMA(0, 1, At, B1); PG8_BAR;
            PG8_LDA(At, 1, 1); PG8_STAGE(PG8_SA(1, 0), a3, voffA);
            PG8_BAR; PG8_WAIT_L(0); PG8_MMA(1, 0, At, B0); PG8_BAR; PG8_SCHED;
            PG8_STAGE(PG8_SB(1, 1), b3 + hstep, voffB);
            PG8_WAIT_V(6); PG8_BAR; PG8_MMA(1, 1, At, B1); PG8_BAR;
            }
        }
        if constexpr (ALIGN_EPI) { if (wr == 0) PG8_BAR; }
        if constexpr (!Epi::AFTER_DRAIN) { E(acc, cur, wr, wc, fr, fq); S.done(cur); }
        if (!has_next) break;
#pragma unroll
        for (int a = 0; a < 2; ++a)
#pragma unroll
            for (int b = 0; b < 2; ++b)
#pragma unroll
                for (int m = 0; m < 4; ++m)
#pragma unroll
                    for (int n = 0; n < 2; ++n) acc[a][b][m][n] = (f32x4){0.f, 0.f, 0.f, 0.f};
        cur = nxt; cA = nA; cB = nB; ++ui;
        if constexpr (ALIGN_EPI) { if (wr == 1) PG8_BAR; }
    }
    PG8_WAIT_V(0);
    if constexpr (!ALIGN_EPI) { if (wr == 0) PG8_BAR; }
    PG8_BAR;
    if constexpr (Epi::AFTER_DRAIN) { E.fused(acc, cur, wr, wc, fr, fq, lds, wid, lane); S.done(cur); }
#undef PG8_SA
#undef PG8_SB
#undef PG8_STAGE
#undef PG8_LDA
#undef PG8_LDB
#undef PG8_MMA
#undef PG8_WAIT_V
#undef PG8_WAIT_L
#undef PG8_BAR
#undef PG8_SCHED
}
}

#define GAS __attribute__((address_space(1)))
#define LAS __attribute__((address_space(3)))
typedef unsigned short bf16;
typedef unsigned v4u __attribute__((ext_vector_type(4)));
typedef float f32x4 __attribute__((ext_vector_type(4)));
typedef short bf16x8 __attribute__((ext_vector_type(8)));
typedef GAS unsigned gu32;
typedef GAS unsigned long long gu64;
#define RLX_AGENT __ATOMIC_RELAXED, __HIP_MEMORY_SCOPE_AGENT
#define LDS_WAIT() asm volatile("s_waitcnt lgkmcnt(0)" ::: "memory")
#define VM_WAIT() asm volatile("s_waitcnt vmcnt(0)" ::: "memory")
__device__ __forceinline__ unsigned long long rt() { return __builtin_amdgcn_s_memrealtime(); }
__device__ __forceinline__ unsigned f2bf(float f) { unsigned u = __builtin_bit_cast(unsigned, f); return (u + 0x7fffu + ((u >> 16) & 1u)) >> 16; }
__device__ __forceinline__ unsigned pk2(float lo, float hi) { return f2bf(lo) | (f2bf(hi) << 16); }

#define XB_TMO      128
#define XB_XCNT(j)  (256  + 64 * (j))
#define XB_XSUB(j)  (1280 + 64 * (j))
#define XB_XGEN(j)  (2304 + 64 * (j))
#define XB_TOP      3328
#define XB_TOPGEN   3392
#define XCD_BAR_WORDS 3456
#define XB_SPIN_CAP (1u << 18)

__device__ __forceinline__ unsigned xb_ld(unsigned* p)              { return __hip_atomic_load(p, __ATOMIC_RELAXED, __HIP_MEMORY_SCOPE_AGENT); }
__device__ __forceinline__ unsigned xb_add(unsigned* p, unsigned v) { return __hip_atomic_fetch_add(p, v, __ATOMIC_RELAXED, __HIP_MEMORY_SCOPE_AGENT); }
__device__ __forceinline__ unsigned xb_xcc_id() { return (unsigned)__builtin_amdgcn_s_getreg((3 << 11) | 20) & 0xFu; }
#define XB_SPIN(cond, bar) do { unsigned _sp = 0; while (cond) { __builtin_amdgcn_s_sleep(1); \
    if ((++_sp & 255u) == 0u) { if (xb_ld(&(bar)[XB_TMO])) break; if (_sp > XB_SPIN_CAP) { atomicAdd(&(bar)[XB_TMO], 1u); break; } } } } while (0)

struct XcdBarrier {
    unsigned* bar; unsigned x;
    volatile LAS unsigned* st;
};

__device__ __forceinline__ XcdBarrier xcd_barrier_post(unsigned* bar, volatile LAS unsigned* st) {
    XcdBarrier b; b.bar = bar; b.x = xb_xcc_id(); b.st = st;
    if (threadIdx.x == 0) (void)xb_add(&bar[XB_XCNT(b.x)], 1u);
    return b;
}
__device__ __forceinline__ void xcd_barrier_complete(unsigned* bar, unsigned x, unsigned& nloc, unsigned& nx) {
    const unsigned G = gridDim.x * gridDim.y * gridDim.z;
    unsigned sum, cnt, mine, sp = 0u;
    for (;;) {
        sum = 0u; cnt = 0u; mine = 0u;
#pragma unroll
        for (unsigned j = 0; j < 16; ++j) { const unsigned c = xb_ld(&bar[XB_XCNT(j)]); sum += c; cnt += (c > 0u) ? 1u : 0u; mine = (j == x) ? c : mine; }
        if (sum == G) break;
        __builtin_amdgcn_s_sleep(1);
        if ((++sp & 255u) == 0u) { if (xb_ld(&bar[XB_TMO])) break; if (sp > XB_SPIN_CAP) { atomicAdd(&bar[XB_TMO], 1u); break; } }
    }
    nloc = mine > 0u ? mine : 1u; nx = cnt > 0u ? cnt : 1u;
}

__device__ __forceinline__ void xcd_barrier(const XcdBarrier& b) {
    asm volatile("s_waitcnt vmcnt(0)" ::: "memory");
    __syncthreads();
    if (threadIdx.x == 0) {
        unsigned* bar = b.bar;
        __builtin_amdgcn_s_waitcnt(0);
        unsigned nloc = b.st[0], nx = b.st[1];
        if (nloc == 0u) { xcd_barrier_complete(bar, b.x, nloc, nx); b.st[0] = nloc; b.st[1] = nx; }
        const unsigned old = xb_add(&bar[XB_XSUB(b.x)], 1u);
        const unsigned gen = old / nloc;
        if (old + 1u == (gen + 1u) * nloc) {
            __builtin_amdgcn_fence(__ATOMIC_RELEASE, "agent");
            asm volatile("s_waitcnt vmcnt(0)" ::: "memory");
            const unsigned og = xb_add(&bar[XB_TOP], 1u);
            const unsigned tg = og / nx;
            if (og + 1u == (tg + 1u) * nx) xb_add(&bar[XB_TOPGEN], 1u);
            else XB_SPIN(xb_ld(&bar[XB_TOPGEN]) == tg, bar);
            __builtin_amdgcn_fence(__ATOMIC_ACQUIRE, "agent");
            xb_add(&bar[XB_XGEN(b.x)], 1u);
            asm volatile("s_waitcnt vmcnt(0)" ::: "memory");
        } else {
            XB_SPIN(xb_ld(&bar[XB_XGEN(b.x)]) == gen, bar);
            __builtin_amdgcn_fence(__ATOMIC_ACQUIRE, "agent");
            asm volatile("s_waitcnt vmcnt(0)" ::: "memory");
        }
    }
    __syncthreads();
}

namespace att {
using bf16x8 = __attribute__((ext_vector_type(8))) short;
using s16x4 = __attribute__((ext_vector_type(4))) short;
using f32x16 = __attribute__((ext_vector_type(16))) float;
using u32x4 = __attribute__((ext_vector_type(4))) unsigned;
typedef __attribute__((address_space(3))) const char* lds_cptr;
typedef short v4i16_t __attribute__((ext_vector_type(4)));
typedef float f32x2_t __attribute__((ext_vector_type(2))); typedef __bf16 bf16x2_t __attribute__((ext_vector_type(2)));
constexpr int SLOTB = 32768, NSLOT = 3, LDS_WSF = NSLOT * SLOTB, STG = 132;
constexpr float C2 = 0.125f * 1.4426950408889634f;
__device__ __forceinline__ int crow(int r, int hi) { return (r & 3) + 8 * (r >> 2) + 4 * hi; }
__device__ __forceinline__ void glds16(const void* gsrc, unsigned lds_dst) { unsigned keep;
    asm volatile("s_mov_b32 %0, m0\n\ts_mov_b32 m0, %2\n\ts_nop 0\n\tglobal_load_lds_dwordx4 %1, off\n\ts_mov_b32 m0, %0" : "=&s"(keep) : "v"(gsrc), "s"(lds_dst) : "memory"); }
__device__ __forceinline__ unsigned cvtpk_s(float lo, float hi) { f32x2_t v = {lo, hi}; bf16x2_t b = __builtin_convertvector(v, bf16x2_t); return __builtin_bit_cast(unsigned, b); }
__device__ __forceinline__ s16x4 vtr(lds_cptr p) { return __builtin_bit_cast(s16x4, __builtin_amdgcn_ds_read_tr16_b64_v4i16((__attribute__((address_space(3))) v4i16_t*)p)); }
#define ATT_WAIT_BAR(N) asm volatile("s_waitcnt vmcnt(" #N ") lgkmcnt(0)\n\ts_barrier" ::: "memory")
#define ATT_MFMA(a, b, c) __builtin_amdgcn_mfma_f32_32x32x16_bf16((a), (b), (c), 0, 0, 0)

template <int THRL, bool DRY = false> __device__ __forceinline__ void attn_unit(unsigned short* Qrows, const unsigned short* Kb, const unsigned short* Vb, int NT, int h, float lam, const float* subln, __attribute__((address_space(3))) char* shm) {
    int tid_ = threadIdx.x; asm volatile("" : "+v"(tid_));
    const int tid = tid_, lane = tid & 63, r32 = lane & 31, hi = lane >> 5; const int wid = __builtin_amdgcn_readfirstlane(tid >> 6); const int qb = wid & 3, mp = wid >> 2;
    const unsigned lds0 = (unsigned)(uintptr_t)shm;
    __attribute__((address_space(3))) float* wsf = (__attribute__((address_space(3))) float*)(shm + LDS_WSF) + wid * 64;
    const unsigned short* ksrc = Kb + (size_t)lane * 1024 + h * 128 + wid * 8;
    const unsigned short* vsrc = Vb + (size_t)(16 * (wid & 3) + (lane >> 2)) * 1024 + h * 128 + (wid >> 2) * 32 + (lane & 3) * 8;
    const unsigned kdst = lds0 + wid * 1024, vdst = lds0 + 16384 + wid * 1024;
#define ATT_DMA(t, slot) do { const size_t to_ = (size_t)(t) * 65536; const unsigned so_ = (unsigned)(slot); \
        glds16(ksrc + to_, (unsigned)__builtin_amdgcn_readfirstlane(kdst + so_)); glds16(ksrc + to_ + 64, (unsigned)__builtin_amdgcn_readfirstlane(kdst + 8192 + so_)); \
        glds16(vsrc + to_, (unsigned)__builtin_amdgcn_readfirstlane(vdst + so_)); glds16(vsrc + to_ + 64, (unsigned)__builtin_amdgcn_readfirstlane(vdst + 8192 + so_)); } while (0)
    bf16x8 qr[4];
    { const unsigned short* Qw = Qrows + (size_t)(qb * 32 + r32) * 1024 + h * 128 + mp * 64 + hi * 8;
#pragma unroll
      for (int d0 = 0; d0 < 4; ++d0) qr[d0] = *(const bf16x8*)(Qw + d0 * 16); }
    ATT_DMA(0, 0);
    if (NT > 1) ATT_DMA(1, SLOTB);
    const lds_cptr kp0 = (lds_cptr)shm + mp * 8192 + hi * 1024 + r32 * 16;
    const lds_cptr vp0 = (lds_cptr)shm + 16384 + ((lane >> 4) & 1) * 32 + (lane & 3) * 8 + (4 * hi + ((lane & 15) >> 2)) * 64;
    float mhat = 0.f, l_reg = 0.f; f32x16 o[4]; f32x16 negm;
#pragma unroll
    for (int d = 0; d < 4; ++d) o[d] = f32x16{};
    negm = f32x16{};
    int sl_cur = 0, sl_nn = 2 * SLOTB;
    for (int t = 0; t < NT; ++t) {
        if (t + 1 < NT) ATT_WAIT_BAR(4); else ATT_WAIT_BAR(0);
        if (t + 2 < NT) ATT_DMA(t + 2, sl_nn);
        f32x16 p0, p1;
        { const lds_cptr kp = kp0 + sl_cur;
#pragma unroll
          for (int d0 = 0; d0 < 4; ++d0) { const bf16x8 k0 = *(const __attribute__((address_space(3))) bf16x8*)(kp + d0 * 2048), k1 = *(const __attribute__((address_space(3))) bf16x8*)(kp + d0 * 2048 + 512);
              p0 = ATT_MFMA(k0, qr[d0], d0 == 0 ? negm : p0); p1 = ATT_MFMA(k1, qr[d0], d0 == 0 ? negm : p1); } }
        float rm;
        { float a = fmaxf(fmaxf(p0[0], p0[1]), p1[0]), b = fmaxf(fmaxf(p0[2], p0[3]), p1[1]); a = fmaxf(fmaxf(a, p1[2]), p1[3]);
#pragma unroll
          for (int r = 4; r < 16; r += 4) { a = fmaxf(fmaxf(a, p0[r]), p0[r + 1]); b = fmaxf(fmaxf(b, p0[r + 2]), p0[r + 3]); a = fmaxf(fmaxf(a, p1[r]), p1[r + 1]); b = fmaxf(fmaxf(b, p1[r + 2]), p1[r + 3]); }
          rm = fmaxf(a, b); auto rr = __builtin_amdgcn_permlane32_swap(__float_as_uint(rm), __float_as_uint(rm), false, false); rm = fmaxf(__uint_as_float(rr[0]), __uint_as_float(rr[1])); }
        if (t == 0 || __any(rm > (float)THRL)) {
            const float dl = (t == 0) ? rm : fmaxf(rm, 0.f); mhat += dl;
#pragma unroll
            for (int r = 0; r < 16; ++r) { p0[r] -= dl; p1[r] -= dl; }
#pragma unroll
            for (int r = 0; r < 16; ++r) negm[r] = -mhat;
            if (t > 0) { const float f = __builtin_amdgcn_exp2f(-dl); l_reg *= f; if (hi == 0) wsf[r32] = f;
                float fr_[16];
#pragma unroll
                for (int r = 0; r < 16; ++r) fr_[r] = wsf[crow(r, hi)];
#pragma unroll
                for (int d = 0; d < 4; ++d)
#pragma unroll
                    for (int r = 0; r < 16; ++r) o[d][r] *= fr_[r]; }
        }
        float sacc = 0.f;
#pragma unroll
        for (int r = 0; r < 16; ++r) { p0[r] = __builtin_amdgcn_exp2f(p0[r]); p1[r] = __builtin_amdgcn_exp2f(p1[r]); sacc += p0[r] + p1[r]; }
        l_reg += sacc;
        u32x4 pw[4];
#pragma unroll
        for (int s = 0; s < 2; ++s) { pw[s] = (u32x4){cvtpk_s(p0[8 * s], p0[8 * s + 1]), cvtpk_s(p0[8 * s + 2], p0[8 * s + 3]), cvtpk_s(p0[8 * s + 4], p0[8 * s + 5]), cvtpk_s(p0[8 * s + 6], p0[8 * s + 7])};
            pw[2 + s] = (u32x4){cvtpk_s(p1[8 * s], p1[8 * s + 1]), cvtpk_s(p1[8 * s + 2], p1[8 * s + 3]), cvtpk_s(p1[8 * s + 4], p1[8 * s + 5]), cvtpk_s(p1[8 * s + 6], p1[8 * s + 7])}; }
        { const lds_cptr vp = vp0 + sl_cur;
#pragma unroll
          for (int db = 0; db < 4; ++db) {
#pragma unroll
              for (int ks = 0; ks < 4; ++ks) { const s16x4 lo = vtr(vp + db * 4096 + ks * 1024), hh = vtr(vp + db * 4096 + ks * 1024 + 512);
                  const bf16x8 vf = (bf16x8){lo[0], lo[1], lo[2], lo[3], hh[0], hh[1], hh[2], hh[3]};
                  o[db] = ATT_MFMA(__builtin_bit_cast(bf16x8, pw[ks]), vf, o[db]); } } }
        sl_cur = (sl_cur == 2 * SLOTB) ? 0 : sl_cur + SLOTB; sl_nn = (sl_nn == 2 * SLOTB) ? 0 : sl_nn + SLOTB;
    }
    { auto rr = __builtin_amdgcn_permlane32_swap(__float_as_uint(l_reg), __float_as_uint(l_reg), false, false); l_reg = __uint_as_float(rr[0]) + __uint_as_float(rr[1]); }
    if (hi == 0) wsf[32 + r32] = l_reg;
    { float rli[16];
#pragma unroll
      for (int r = 0; r < 16; ++r) rli[r] = 1.0f / wsf[32 + crow(r, hi)];
#pragma unroll
      for (int d = 0; d < 4; ++d)
#pragma unroll
          for (int r = 0; r < 16; ++r) o[d][r] *= rli[r]; }
    ATT_WAIT_BAR(0);
    __attribute__((address_space(3))) float* stg = (__attribute__((address_space(3))) float*)shm + qb * (32 * STG);
    if (mp == 1) {
#pragma unroll
        for (int d = 0; d < 4; ++d)
#pragma unroll
            for (int r = 0; r < 16; ++r) stg[crow(r, hi) * STG + d * 32 + r32] = o[d][r];
    }
    ATT_WAIT_BAR(0);
    if (mp == 0) {
#pragma unroll
        for (int d = 0; d < 4; ++d)
#pragma unroll
            for (int r = 0; r < 16; ++r) { const int a_ = crow(r, hi) * STG + d * 32 + r32; const float res = o[d][r] - lam * stg[a_]; stg[a_] = res; }
        asm volatile("s_waitcnt lgkmcnt(0)" ::: "memory");
        const __attribute__((address_space(3))) float* rowp = stg + r32 * STG + hi * 64;
        f32x4 v[16]; float ssq = 0.f;
#pragma unroll
        for (int i = 0; i < 16; ++i) { v[i] = *(const __attribute__((address_space(3))) f32x4*)(rowp + 4 * i); ssq += (v[i][0] * v[i][0] + v[i][1] * v[i][1]) + (v[i][2] * v[i][2] + v[i][3] * v[i][3]); }
        { auto rr = __builtin_amdgcn_permlane32_swap(__float_as_uint(ssq), __float_as_uint(ssq), false, false); ssq = __uint_as_float(rr[0]) + __uint_as_float(rr[1]); }
        const float rs = 0.8f / sqrtf(ssq * (1.0f / 128.0f) + 1e-6f);
        unsigned short* op = Qrows + (size_t)(qb * 32 + r32) * 1024 + h * 128 + hi * 64; const float* sw = subln + hi * 64;
#pragma unroll
        for (int i = 0; i < 16; i += 2) { const f32x4 g0 = *(const f32x4*)(sw + 4 * i), g1 = *(const f32x4*)(sw + 4 * i + 4); const f32x4 a = v[i] * g0 * rs, b = v[i + 1] * g1 * rs;
            u32x4 w; w.x = cvtpk_s(a[0], a[1]); w.y = cvtpk_s(a[2], a[3]); w.z = cvtpk_s(b[0], b[1]); w.w = cvtpk_s(b[2], b[3]); if (!DRY) *(u32x4*)(op + 4 * i) = w; else asm volatile("" :: "v"(w.x), "v"(w.y), "v"(w.z), "v"(w.w)); }
    }
    asm volatile("s_waitcnt vmcnt(0)" ::: "memory");
    ATT_WAIT_BAR(0);
#undef ATT_DMA
}
}

struct Args { const float* in[26]; float* out; unsigned char* ws; };
enum { I_XP = 0, I_XS, I_CK, I_CV, I_C, I_CCTX, I_WADA, I_BADA, I_WIN, I_WPOOL, I_PSCALE, I_WPA, I_WPB, I_WOUT, I_LQ1, I_LK1, I_LQ2, I_LK2, I_SUBLN, I_N1, I_N2, I_WFI, I_CONVW, I_CONVB, I_WFO, I_FN };

struct Ctx { LAS unsigned char* lds; int tid, lane, wave, G, bid; };
template <int I> __device__ __forceinline__ unsigned long long karg_raw() {
    unsigned long long v; auto kp = __builtin_amdgcn_kernarg_segment_ptr();
    asm volatile("s_load_dwordx2 %0, %1, %2\n\ts_waitcnt lgkmcnt(0)" : "=s"(v) : "s"(kp), "n"(I * 8) : "memory");
    return v;
}
template <int I> __device__ __forceinline__ const float* karg() { return (const float*)karg_raw<I>(); }
__device__ __forceinline__ float* kout() { return (float*)karg_raw<26>(); }
__device__ __forceinline__ unsigned char* kws() { return (unsigned char*)karg_raw<27>(); }

__device__ __forceinline__ float wave_sum(float v) {
#pragma unroll
    for (int o = 1; o < 64; o <<= 1) v += __shfl_xor(v, o);
    return v;
}
__device__ __forceinline__ float bf2f(unsigned short b) { return __builtin_bit_cast(float, (unsigned)b << 16); }
__device__ __forceinline__ float bflo(unsigned w) { return __builtin_bit_cast(float, w << 16); }
__device__ __forceinline__ float bfhi(unsigned w) { return __builtin_bit_cast(float, w & 0xffff0000u); }

__device__ __forceinline__ void tr_item(const float* W, int N, bf16* WT, int ldwt, int k0, int n0, int drow0, int dcol0, LAS float* scr, int lane) {
#pragma unroll 8
    for (int i = 0; i < 32; ++i) { const int kk = 2 * i + (lane >> 5); scr[kk * 33 + (lane & 31)] = W[(size_t)(k0 + kk) * N + n0 + (lane & 31)]; }
    LDS_WAIT(); asm volatile("" ::: "memory");
    const int c = lane & 7;
#pragma unroll
    for (int j = 0; j < 4; ++j) { const int n = (lane >> 3) + 8 * j; const LAS float* s = scr + (8 * c) * 33 + n;
        v4u o; o.x = pk2(s[0 * 33], s[1 * 33]); o.y = pk2(s[2 * 33], s[3 * 33]); o.z = pk2(s[4 * 33], s[5 * 33]); o.w = pk2(s[6 * 33], s[7 * 33]);
        *(GAS v4u*)(WT + (size_t)(drow0 + n) * ldwt + dcol0 + k0 + 8 * c) = o; }
    LDS_WAIT(); asm volatile("" ::: "memory");
}
__device__ __forceinline__ void p0_transposes_a(const Ctx& C) {
    LAS float* scr = (LAS float*)(C.lds + RING_OFF + C.wave * 16384);
    const int gw = C.bid * NWAVES + C.wave, NGW = C.G * NWAVES;
    constexpr int I0 = (1024 / 64) * (5632 / 32), I1 = (512 / 64) * (1024 / 32), I2 = (1024 / 64) * (1024 / 32), I3 = I2, I4 = 4 * 2 * 4;
    unsigned char* ws = kws(); const float* w0 = karg<I_WIN>(); const float* w1 = karg<I_WPA>(); const float* w2 = karg<I_WPB>(); const float* w3 = karg<I_WOUT>(); const float* w4 = karg<I_WPOOL>();
    for (int it = gw; it < I0 + I1 + I2 + I3 + I4; it += NGW) {
        int r = it;
        if (r < I0) { const int kb = r / 176, nb = r % 176; tr_item(w0, 5632, (bf16*)(ws + WS_WIN), 1024, 64 * kb, 32 * nb, 32 * nb, 0, scr, C.lane); continue; } r -= I0;
        if (r < I1) { const int kb = r / 32, nb = r % 32; tr_item(w1, 1024, (bf16*)(ws + WS_WPA), 512, 64 * kb, 32 * nb, 32 * nb, 0, scr, C.lane); continue; } r -= I1;
        if (r < I2) { const int kb = r / 32, nb = r % 32; tr_item(w2, 1024, (bf16*)(ws + WS_WPB), 1024, 64 * kb, 32 * nb, 32 * nb, 0, scr, C.lane); continue; } r -= I2;
        if (r < I3) { const int kb = r / 32, nb = r % 32; tr_item(w3, 1024, (bf16*)(ws + WS_WOUT), 1024, 64 * kb, 32 * nb, 32 * nb, 0, scr, C.lane); continue; } r -= I3;
        { const int g = r >> 3, kb = (r >> 2) & 1, nb = r & 3; tr_item(w4 + (size_t)g * 16384, 128, (bf16*)(ws + WS_WPOOLT), 512, 64 * kb, 32 * nb, g * 128 + 32 * nb, g * 128, scr, C.lane); }
    }
    for (int i = C.bid * 512 + C.tid; i < 12 * 128 * 16; i += C.G * 512) { const int blk = i >> 11, rr = (i >> 4) & 127, c8 = (i & 15) * 8; const int gr = blk / 3, gcx = blk % 3, gc = gcx + (gcx >= gr ? 1 : 0);
        *(v4u*)((bf16*)(ws + WS_WPOOLT) + (size_t)(gr * 128 + rr) * 512 + gc * 128 + c8) = (v4u){0u, 0u, 0u, 0u}; }
}
__device__ __forceinline__ void p0_transposes_b(const Ctx& C) {
    LAS float* scr = (LAS float*)(C.lds + RING_OFF + C.wave * 16384);
    const int gw = C.bid * NWAVES + C.wave, NGW = C.G * NWAVES;
    constexpr int I0 = (1024 / 64) * (5632 / 32), I1 = (2816 / 64) * (1024 / 32);
    unsigned char* ws = kws(); const float* w0 = karg<I_WFI>(); const float* w1 = karg<I_WFO>();
    for (int it = gw; it < I0 + I1; it += NGW) {
        int r = it;
        if (r < I0) { const int kb = r / 176, nb = r % 176, n0 = 32 * nb, half = n0 >= 2816, nn = n0 - half * 2816; tr_item(w0, 5632, (bf16*)(ws + WS_WFI), 1024, 64 * kb, n0, (nn >> 7) * 256 + half * 128 + (nn & 127), 0, scr, C.lane); continue; } r -= I0;
        { const int kb = r / 32, nb = r % 32; tr_item(w1, 1024, (bf16*)(ws + WS_WFO), 2816, 64 * kb, 32 * nb, 32 * nb, 0, scr, C.lane); }
    }
}
__device__ __forceinline__ void p0_mod(const Ctx& C) {
    if (C.bid >= 96) return;
    const float* cctx = karg<I_CCTX>(); const float* cc = karg<I_C>(); const float* wada = karg<I_WADA>(); const float* bada = karg<I_BADA>();
    LAS float* s = (LAS float*)(C.lds);
    LAS float* red = s + 9 * 1024;
    for (int i = C.tid; i < 9 * 1024; i += 512) { const int r = i >> 10, k = i & 1023; const float v = r == 0 ? cctx[k] : cc[(r - 1) * 1024 + k]; s[i] = v / (1.0f + __expf(-v)); }
    __syncthreads();
    float* mod = (float*)(kws() + WS_MISC);
    for (int it = C.bid; it < 96; it += C.G) {
        const int n = it * 64 + C.lane, k0 = C.wave * 128; float acc[9];
#pragma unroll
        for (int r = 0; r < 9; ++r) acc[r] = 0.f;
        const float* w = wada + (size_t)k0 * 6144 + n;
#pragma unroll 4
        for (int k = 0; k < 128; ++k) { const float wv = w[(size_t)k * 6144];
#pragma unroll
            for (int r = 0; r < 9; ++r) acc[r] += s[r * 1024 + k0 + k] * wv; }
#pragma unroll
        for (int r = 0; r < 9; ++r) red[(C.wave * 9 + r) * 64 + C.lane] = acc[r];
        __syncthreads();
        for (int i = C.tid; i < 576; i += 512) { const int r = i >> 6, c = i & 63; float t = bada[it * 64 + c];
#pragma unroll
            for (int wv = 0; wv < 8; ++wv) t += red[(wv * 9 + r) * 64 + c];
            mod[r * 6144 + it * 64 + c] = t; }
        __syncthreads();
    }
}
__device__ __forceinline__ void p0_misc(const Ctx& C) {
    unsigned char* ws = kws(); const float* ck = karg<I_CK>(); const float* cv = karg<I_CV>();
    const int gt = C.bid * 512 + C.tid, NT = C.G * 512;
    for (int i = gt; i < 2 * 262144; i += NT) {
        const int which = i >= 262144, j = which ? i - 262144 : i; const int row = j >> 7, c8 = (j & 127) * 8;
        const float* src = (which ? cv : ck) + (size_t)row * 1024 + c8;
        const f32x4 x0 = *(const f32x4*)src, x1 = *(const f32x4*)(src + 4);
        v4u o; o.x = pk2(x0[0], x0[1]); o.y = pk2(x0[2], x0[3]); o.z = pk2(x1[0], x1[1]); o.w = pk2(x1[2], x1[3]);
        const int b = row >> 8, t = row & 255;
        *(v4u*)((bf16*)(ws + (which ? WS_VS : WS_KS)) + (size_t)(b * LKV_S + t) * 1024 + c8) = o;
    }
    if (C.bid == C.G - 1) {
        float* rc = (float*)(ws + WS_MISC + MISC_ROPEC); float* rs = (float*)(ws + WS_MISC + MISC_ROPES);
        for (int i = C.tid; i < 1024; i += 512) { const int pos = i >> 4, f = i & 15; const float inv = powf(10000.0f, -(float)f / 16.0f); const float ang = (float)pos * inv; rc[i] = cosf(ang); rs[i] = sinf(ang); }
        if (C.tid == 0) { const float* q1 = karg<I_LQ1>(); const float* k1 = karg<I_LK1>(); const float* q2 = karg<I_LQ2>(); const float* k2 = karg<I_LK2>(); float s1 = 0.f, s2 = 0.f; for (int i = 0; i < 64; ++i) { s1 += q1[i] * k1[i]; s2 += q2[i] * k2[i]; }
            *(float*)(ws + WS_MISC + MISC_LAM) = expf(s1) - expf(s2) + 0.2f; }
    }
}
__device__ __forceinline__ void modulate_rows(const Ctx& C, const float* xp, const float* xs, const float* g, const float* mod, int shift_off, int scale_off, bf16* H) {
    const int gw = C.bid * NWAVES + C.wave, NGW = C.G * NWAVES;
    for (int row = gw; row < MTOK; row += NGW) {
        const float* xr = row < TOK_P ? xp + (size_t)row * DM : xs + (size_t)(row - TOK_P) * DM;
        const float* mr = mod + (row < TOK_P ? 0 : 1 + ((row - TOK_P) >> 11)) * 6144;
        f32x4 v[4]; float ss = 0.f;
#pragma unroll
        for (int j = 0; j < 4; ++j) { v[j] = *(const f32x4*)(xr + 4 * C.lane + 256 * j); ss += (v[j][0] * v[j][0] + v[j][1] * v[j][1]) + (v[j][2] * v[j][2] + v[j][3] * v[j][3]); }
        const float rstd = 1.0f / sqrtf(wave_sum(ss) * (1.0f / DM) + EPS);
#pragma unroll
        for (int j = 0; j < 4; ++j) { const int c = 4 * C.lane + 256 * j; const f32x4 gg = *(const f32x4*)(g + c), sc = *(const f32x4*)(mr + scale_off + c), sh = *(const f32x4*)(mr + shift_off + c);
            const f32x4 o = v[j] * rstd * gg * (sc + 1.0f) + sh;
            unsigned long long w = (unsigned long long)pk2(o[0], o[1]) | ((unsigned long long)pk2(o[2], o[3]) << 32);
            *(unsigned long long*)(H + (size_t)row * DM + c) = w; }
    }
}
__device__ __forceinline__ void final_norm_rows(const Ctx& C, float* X, const float* g) {
    const int gw = C.bid * NWAVES + C.wave, NGW = C.G * NWAVES;
    for (int row = gw; row < MTOK; row += NGW) {
        float* xr = X + (size_t)row * DM; f32x4 v[4]; float ss = 0.f;
#pragma unroll
        for (int j = 0; j < 4; ++j) { v[j] = *(const f32x4*)(xr + 4 * C.lane + 256 * j); ss += (v[j][0] * v[j][0] + v[j][1] * v[j][1]) + (v[j][2] * v[j][2] + v[j][3] * v[j][3]); }
        const float rstd = 1.0f / sqrtf(wave_sum(ss) * (1.0f / DM) + EPS);
#pragma unroll
        for (int j = 0; j < 4; ++j) { const int c = 4 * C.lane + 256 * j; const f32x4 gg = *(const f32x4*)(g + c); *(f32x4*)(xr + c) = v[j] * rstd * gg; }
    }
}

template <bool DRY = false> __device__ __forceinline__ void attn_phase(const Ctx& C) {
    unsigned char* ws = kws(); const float* subln = karg<I_SUBLN>();
    const float lam = __hip_atomic_load((float*)(ws + WS_MISC + MISC_LAM), __ATOMIC_RELAXED, __HIP_MEMORY_SCOPE_AGENT);
    const int vcu = (C.G % 8 == 0) ? (C.bid % 8) * (C.G / 8) + C.bid / 8 : C.bid;
    bf16* Q = (bf16*)(ws + WS_Q);
    for (int u = vcu; u < 1536; u += C.G) {
        bf16* Qrows; const bf16 *Kb, *Vb; int NT, h;
        if (u < 1024) { const int i = u >> 8, v = u & 255, x = v >> 5, c = v & 31, bh = x * 8 + i * 2 + (c >> 4), b = bh >> 3; h = bh & 7;
            Qrows = Q + (size_t)(TOK_P + b * SEQ_S + (c & 15) * 128) * 1024; Kb = (const bf16*)(ws + WS_KS) + (size_t)b * LKV_S * 1024; Vb = (const bf16*)(ws + WS_VS) + (size_t)b * LKV_S * 1024; NT = LKV_S / 64; }
        else { const int j = u - 1024, bh = j >> 1, b = bh >> 3; h = bh & 7;
            Qrows = Q + (size_t)(b * SEQ_P + (j & 1) * 128) * 1024; Kb = (const bf16*)(ws + WS_KP) + (size_t)b * SEQ_P * 1024; Vb = (const bf16*)(ws + WS_VP) + (size_t)b * SEQ_P * 1024; NT = SEQ_P / 64; }
        att::attn_unit<8, DRY>(Qrows, Kb, Vb, NT, h, lam, subln, (__attribute__((address_space(3))) char*)C.lds);
    }
}
__device__ __forceinline__ void pooled_rows(const Ctx& C) {
    unsigned char* ws = kws(); const bf16* U = (const bf16*)(ws + WS_U); bf16* PO = (bf16*)(ws + WS_POOLED);
    for (int i = C.bid * 512 + C.tid; i < MTOK * 64; i += C.G * 512) { const int row = i >> 6, c8 = (i & 63) * 8, g = c8 >> 7; int S, t;
        if (row < TOK_P) { S = SEQ_P; t = row & (SEQ_P - 1); } else { S = SEQ_S; t = (row - TOK_P) & (SEQ_S - 1); }
        const int hw = 1 << g, lo = t - hw < 0 ? 0 : t - hw, hi = t + hw > S ? S : t + hw; const bf16* up = U + (size_t)(row - t) * DPOOL + c8;
        float s[8];
#pragma unroll
        for (int j = 0; j < 8; ++j) s[j] = 0.f;
        for (int r = lo; r < hi; ++r) { const v4u w = *(const v4u*)(up + (size_t)r * DPOOL);
            s[0] += bflo(w.x); s[1] += bfhi(w.x); s[2] += bflo(w.y); s[3] += bfhi(w.y); s[4] += bflo(w.z); s[5] += bfhi(w.z); s[6] += bflo(w.w); s[7] += bfhi(w.w); }
        const v4u me = *(const v4u*)(up + (size_t)t * DPOOL); const float inv = 1.0f / (float)(hi - lo);
        v4u o; o.x = pk2(s[0] * inv - bflo(me.x), s[1] * inv - bfhi(me.x)); o.y = pk2(s[2] * inv - bflo(me.y), s[3] * inv - bfhi(me.y));
        o.z = pk2(s[4] * inv - bflo(me.z), s[5] * inv - bfhi(me.z)); o.w = pk2(s[6] * inv - bflo(me.w), s[7] * inv - bfhi(me.w));
        *(v4u*)(PO + (size_t)row * DPOOL + c8) = o; }
}
__device__ __forceinline__ void ffn_fixup(const Ctx& C) {
    unsigned char* ws = kws(); const float* side = (const float*)(ws + WS_SIDE); bf16* ACT = (bf16*)(ws + WS_ACT); const float* cw = karg<I_CONVW>(); const float* cb = karg<I_CONVB>();
    for (int i = C.bid * 512 + C.tid; i < 64 * 2 * 704; i += C.G * 512) { const int c4 = (i % 704) * 4, which = (i / 704) & 1, pm = 32 + i / 1408; const int pn = c4 >> 7, c = c4 & 127;
        if (which == 0 ? ((pm - 32) & 7) == 0 : ((pm - 32) & 7) == 7) continue;
        const float* s0 = side + (size_t)((pm * 22 + pn) * 6) * 128 + c; f32x4 pv, av, nv, uv;
        if (which == 0) { pv = *(const f32x4*)(s0 - (size_t)22 * 6 * 128 + 3 * 128); av = *(const f32x4*)(s0); nv = *(const f32x4*)(s0 + 128); uv = *(const f32x4*)(s0 + 4 * 128); }
        else { pv = *(const f32x4*)(s0 + 2 * 128); av = *(const f32x4*)(s0 + 3 * 128); nv = *(const f32x4*)(s0 + (size_t)22 * 6 * 128); uv = *(const f32x4*)(s0 + 5 * 128); }
        f32x4 cv = *(const f32x4*)(cw + c4) * pv + *(const f32x4*)(cw + 2816 + c4) * av + *(const f32x4*)(cw + 5632 + c4) * nv + *(const f32x4*)(cb + c4);
#pragma unroll
        for (int j = 0; j < 4; ++j) cv[j] = cv[j] / (1.0f + __expf(-cv[j])) * uv[j];
        unsigned long long w = (unsigned long long)pk2(cv[0], cv[1]) | ((unsigned long long)pk2(cv[2], cv[3]) << 32);
        *(unsigned long long*)(ACT + (size_t)(pm * 256 + (which ? 255 : 0)) * DFF + c4) = w; }
}

#ifndef PHASE_MASK
#define PHASE_MASK 0xffffffffu
#endif
#ifndef REPEAT_MASK
#define REPEAT_MASK 0u
#endif
#define PH(k) if constexpr (((PHASE_MASK) >> (k)) & 1u) for (int rep_ = 0; rep_ < (int)(((REPEAT_MASK) >> (k)) & 1u) + 1; ++rep_)
__global__ void __launch_bounds__(NWAVES * 64, 2) fwd_kernel(Args a_unused) {
    extern __shared__ __attribute__((aligned(16))) unsigned char lds_raw[];
#define MKCTX() Ctx C; { int t_ = threadIdx.x; asm volatile("" : "+v"(t_)); C.lds = (LAS unsigned char*)lds_raw; C.tid = t_; C.lane = t_ & 63; C.wave = __builtin_amdgcn_readfirstlane(t_ >> 6); C.G = gridDim.x; C.bid = blockIdx.x; }
    { MKCTX(); for (int u = C.tid; u < (LDS_BYTES - LDSCTL_OFF) / 4; u += NWAVES * 64) ((LAS unsigned*)(C.lds + LDSCTL_OFF))[u] = 0u; }
    __syncthreads();
    (void)xcd_barrier_post((unsigned*)(kws() + WS_CTL) + CW_BAR, (volatile LAS unsigned*)((LAS unsigned char*)lds_raw + MISC_OFF) + 8);
#define GRID_BAR() do { XcdBarrier b_; b_.bar = (unsigned*)(kws() + WS_CTL) + CW_BAR; b_.x = xb_xcc_id(); b_.st = (volatile LAS unsigned*)((LAS unsigned char*)lds_raw + MISC_OFF) + 8; xcd_barrier(b_); } while (0)
#define GEMM_PHASE(EPI, Aoff, Boff, MM, NN, KK, ...) { unsigned char* ws = kws(); pg8::Gemm g{(const pg8::bf16_t*)(ws + (Aoff)), (const pg8::bf16_t*)(ws + (Boff)), (MM), (NN), (KK)}; pg8::StaticOrder S; S.init((MM), (NN), C.G, C.bid); \
      EPI E{__VA_ARGS__}; pg8::gemm_phase<EPI, pg8::StaticOrder, true, true>(C.lds + RING_OFF, g, S, E); }

    PH(0) { MKCTX(); { p0_transposes_a(C); __syncthreads(); p0_mod(C); __syncthreads(); p0_misc(C); } }
    GRID_BAR();
    PH(1) { MKCTX(); { unsigned char* ws = kws(); modulate_rows(C, karg<I_XP>(), karg<I_XS>(), karg<I_N1>(), (const float*)(ws + WS_MISC), 0, 1024, (bf16*)(ws + WS_H)); } }
    GRID_BAR();
    PH(2) { MKCTX(); GEMM_PHASE(pg8::EpiProj, WS_H, WS_WIN, MTOK, DIN, DM, ws, kout()) }
    GRID_BAR();
    PH(3) { MKCTX(); pooled_rows(C); }
    GRID_BAR();
    PH(4) { MKCTX(); GEMM_PHASE(pg8::EpiPoolMix, WS_POOLED, WS_WPOOLT, MTOK, DPOOL, DPOOL, (bf16*)(ws + WS_MIXED), karg<I_PSCALE>()) }
#ifdef REPEAT_ATTN
    for (int rep_ = 0; rep_ < REPEAT_ATTN; ++rep_) { MKCTX(); attn_phase<true>(C); }
#endif
    PH(5) { MKCTX(); attn_phase<false>(C); }
    GRID_BAR();
    PH(6) { MKCTX(); GEMM_PHASE(pg8::EpiGate<0>, WS_MIXED, WS_WPA, MTOK, DM, DPOOL, (bf16*)(ws + WS_MERGED), (const bf16*)kout()) }
    PH(7) { MKCTX(); GEMM_PHASE(pg8::EpiGate<1>, WS_Q, WS_WPB, MTOK, DM, DM, (bf16*)(ws + WS_MERGED), (const bf16*)kout()) }
    GRID_BAR();
    PH(8) { MKCTX(); GEMM_PHASE(pg8::EpiResid, WS_MERGED, WS_WOUT, MTOK, DM, DM, karg<I_XP>(), karg<I_XS>(), kout(), (const float*)(ws + WS_MISC), 2048, 0) }
    GRID_BAR();
    PH(9) { MKCTX(); { unsigned char* ws = kws(); float* X = kout(); modulate_rows(C, X, X + (size_t)TOK_P * DM, karg<I_N2>(), (const float*)(ws + WS_MISC), 3072, 4096, (bf16*)(ws + WS_H)); __syncthreads(); p0_transposes_b(C); } }
    GRID_BAR();
    PH(10) { MKCTX(); GEMM_PHASE(pg8::EpiFfn, WS_H, WS_WFI, MTOK, DIN, DM, (bf16*)(ws + WS_ACT), karg<I_CONVW>(), karg<I_CONVB>(), (float*)(ws + WS_SIDE), (PG8_LAS float*)(C.lds + LDS_EDGE_OFF)) }
    GRID_BAR();
    PH(11) { MKCTX(); ffn_fixup(C); }
    GRID_BAR();
    PH(12) { MKCTX(); { float* X = kout(); GEMM_PHASE(pg8::EpiResid, WS_ACT, WS_WFO, MTOK, DM, DFF, X, X + (size_t)TOK_P * DM, X, (const float*)(ws + WS_MISC), 5120, 0) } }
    GRID_BAR();
    PH(13) { MKCTX(); final_norm_rows(C, kout(), karg<I_FN>()); }
}

extern "C" void kernel_launch(void* const* d_in, const int* in_sizes, int n_in, void* d_out, int out_size, void* d_ws, size_t ws_size, hipStream_t stream) {
    static int grid = 0;
    if (grid == 0) {
        if (n_in != 26 || in_sizes[0] != TOK_P * DM || out_size != 41943040 || ws_size < WS_END) { fprintf(stderr, "kernel_launch: unexpected shapes: n_in %d in0 %d out %d ws %zu; nothing launched\n", n_in, n_in > 0 ? in_sizes[0] : -1, out_size, ws_size); grid = -1; return; }
        int dev = 0, cus = 0, per_cu = 0;
        if (hipGetDevice(&dev) != hipSuccess || hipDeviceGetAttribute(&cus, hipDeviceAttributeMultiprocessorCount, dev) != hipSuccess) { grid = -1; return; }
        if (hipFuncSetAttribute((const void*)fwd_kernel, hipFuncAttributeMaxDynamicSharedMemorySize, LDS_BYTES) != hipSuccess) { fprintf(stderr, "kernel_launch: hipFuncSetAttribute failed\n"); grid = -1; return; }
        if (hipOccupancyMaxActiveBlocksPerMultiprocessor(&per_cu, (const void*)fwd_kernel, NWAVES * 64, LDS_BYTES) != hipSuccess || per_cu < 1) fprintf(stderr, "kernel_launch: note: occupancy query reports %d\n", per_cu);
        (void)hipGetLastError();
        grid = cus;
    }
    if (grid < 0) return;
    if (hipMemsetAsync((char*)d_ws + WS_CTL, 0, CTL_ZERO_BYTES, stream) != hipSuccess) return;
    Args a{};
    for (int i = 0; i < 26; ++i) a.in[i] = (const float*)d_in[i];
    a.out = (float*)d_out; a.ws = (unsigned char*)d_ws;
    hipLaunchKernelGGL(fwd_kernel, dim3(grid), dim3(NWAVES * 64), LDS_BYTES, stream, a);
}
```
